# Optimizing an MI355X kernel written in HIP

```python
import math
import jax
import jax.numpy as jnp
from jax import lax

D_MODEL = 1024
BATCH = 16
SEQ = 256
DEPTH = 2
DEC_BATCH = 2
DEC_SEQ = 2048
PAST_LEN = 256

F32 = jnp.float32
GRID_W = 64
BRANCH = D_MODEL // 4
MIX_WIDTH = 4 * BRANCH
EPS = 1e-6
ROPE_BASE = 10000.0
Q_BLOCK = 128
DA_HEADS = 4
DA_V = BRANCH // DA_HEADS
DA_QK = DA_V // 2
S5_CH = 16
S5_GROUPS = BRANCH // S5_CH
S5_STATE = 64
S5_DT_MIN = 1e-3
S5_DT_MAX = 1e-1
HG_HEADS = 4
HG_DK = BRANCH // HG_HEADS
HG_DV = BRANCH // HG_HEADS
HG_CHUNK = 64
MLA_HEADS = 4
MLA_NOPE = 64
MLA_ROPE = 32
MLA_V = BRANCH // MLA_HEADS
MLA_Q_RANK = 192
MLA_KV_RANK = 128

IN_SIZES = (
    DA_HEADS * 2 * DA_QK,
    DA_HEADS * 2 * DA_QK,
    DA_HEADS * DA_V,
    BRANCH,
    BRANCH,
    BRANCH,
    HG_HEADS * HG_DK,
    HG_HEADS * HG_DK,
    HG_HEADS * HG_DK,
    HG_HEADS * HG_DV,
    BRANCH,
    MLA_Q_RANK,
    MLA_KV_RANK,
    MLA_ROPE,
    BRANCH,
)
IN_WIDTH = sum(IN_SIZES)

kernel_name = "hybrid_diff_s5_hgrn2_mla_prefix_step"


def rms_norm(x):
    xf = x.astype(F32)
    return xf * lax.rsqrt(jnp.mean(xf * xf, axis=-1, keepdims=True) + EPS)


def split_columns(z):
    out, start = [], 0
    for n in IN_SIZES:
        out.append(z[..., start:start + n])
        start += n
    return out


def rope_2d(x, row, col):
    half = x.shape[-1] // 2
    nf = half // 2
    inv_freq = ROPE_BASE ** (-jnp.arange(nf, dtype=F32) / nf)
    bshape = (1, x.shape[1]) + (1,) * (x.ndim - 3) + (nf,)
    xf = x.astype(F32)

    def rot(xp, pos):
        ang = (pos.astype(F32)[:, None] * inv_freq).reshape(bshape)
        cos, sin = jnp.cos(ang), jnp.sin(ang)
        x1, x2 = xp[..., :nf], xp[..., nf:]
        return jnp.concatenate([x1 * cos - x2 * sin, x1 * sin + x2 * cos], axis=-1)

    return jnp.concatenate([rot(xf[..., :half], row), rot(xf[..., half:], col)], axis=-1).astype(x.dtype)


def over_query_blocks(fn, q):
    B, L = q.shape[:2]
    nb = L // Q_BLOCK
    qb = jnp.moveaxis(q.reshape((B, nb, Q_BLOCK) + q.shape[2:]), 1, 0)
    o = jnp.moveaxis(lax.map(fn, qb), 0, 1)
    return o.reshape((B, L) + o.shape[3:])


def blocked_attention(q, k, v, scale):
    def one(qb):
        s = jnp.einsum("bqhd,bkhd->bhqk", qb, k).astype(F32) * scale
        p = jax.nn.softmax(s, axis=-1).astype(v.dtype)
        return jnp.einsum("bhqk,bkhd->bqhd", p, v)
    return over_query_blocks(one, q)


def diff_attn_branch(q_in, k_in, v_in, gate, lam_vec, norm_g, lam_init, pos, ctx):
    B, L, _ = q_in.shape
    dt = q_in.dtype
    q = q_in.reshape(B, L, DA_HEADS, 2, DA_QK)
    k = k_in.reshape(B, L, DA_HEADS, 2, DA_QK)
    v = v_in.reshape(B, L, DA_HEADS, DA_V)
    if ctx is None:
        q_r, k_all, v_all = q, k, v
    else:
        ck, cv = ctx
        q_r = rope_2d(q, *pos)
        ck = ck.astype(dt).reshape(ck.shape[:3] + (2, DA_QK))
        k_all = jnp.concatenate([rope_2d(k, *pos), ck], axis=1)
        v_all = jnp.concatenate([v, cv.astype(dt)], axis=1)
    lv = lam_vec.astype(F32)
    lam = jnp.exp(jnp.sum(lv[0] * lv[1])) - jnp.exp(jnp.sum(lv[2] * lv[3])) + lam_init
    sm_scale = DA_QK ** -0.5

    def block(qb):
        s = jnp.einsum("bqhcd,bkhcd->bchqk", qb, k_all).astype(F32) * sm_scale
        p = jax.nn.softmax(s, axis=-1)
        a = (p[:, 0] - lam * p[:, 1]).astype(v_all.dtype)
        return jnp.einsum("bhqk,bkhd->bqhd", a, v_all)

    o = over_query_blocks(block, q_r)
    o = rms_norm(o) * norm_g.astype(F32) * (1.0 - lam_init)
    out = o.reshape(B, L, BRANCH) * jax.nn.silu(gate.astype(F32))
    return out.astype(dt), (k.reshape(B, L, DA_HEADS, 2 * DA_QK), v)


def s5_discretize(a_re, a_im, log_dt, b_re, b_im):
    a_re, a_im = a_re.astype(F32), a_im.astype(F32)
    step = jnp.exp(log_dt.astype(F32))[:, None]
    mag = jnp.exp(a_re * step)
    ab_re, ab_im = mag * jnp.cos(a_im * step), mag * jnp.sin(a_im * step)
    den = a_re * a_re + a_im * a_im
    f_re = ((ab_re - 1.0) * a_re + ab_im * a_im) / den
    f_im = (ab_im * a_re - (ab_re - 1.0) * a_im) / den
    b_re, b_im = b_re.astype(F32), b_im.astype(F32)
    bb_re = f_re[..., None] * b_re - f_im[..., None] * b_im
    bb_im = f_re[..., None] * b_im + f_im[..., None] * b_re
    return ab_re, ab_im, bb_re, bb_im


def s5_scan(u, ab_re, ab_im, bb_re, bb_im, h0, reverse):
    bu_re = jnp.einsum("gph,blgh->blgp", bb_re, u)
    bu_im = jnp.einsum("gph,blgh->blgp", bb_im, u)
    a_re = jnp.broadcast_to(ab_re, bu_re.shape)
    a_im = jnp.broadcast_to(ab_im, bu_re.shape)

    def combine(e1, e2):
        a1r, a1i, b1r, b1i = e1
        a2r, a2i, b2r, b2i = e2
        return (a2r * a1r - a2i * a1i, a2r * a1i + a2i * a1r,
                a2r * b1r - a2i * b1i + b2r, a2r * b1i + a2i * b1r + b2i)

    ar, ai, hr, hi = lax.associative_scan(combine, (a_re, a_im, bu_re, bu_im), axis=1, reverse=reverse)
    if h0 is not None:
        h0r, h0i = h0[0][:, None], h0[1][:, None]
        hr, hi = hr + ar * h0r - ai * h0i, hi + ar * h0i + ai * h0r
    return hr, hi


def s5_branch(u, gate, P, l, h0):
    B, L, _ = u.shape
    uf = u.astype(F32)
    ug = uf.reshape(B, L, S5_GROUPS, S5_CH)
    y = uf * P["s5_d"][l].astype(F32)
    finals = []
    for d in range(2):
        ab_re, ab_im, bb_re, bb_im = s5_discretize(P["s5_a_re"][l, d], P["s5_a_im"][l, d], P["s5_log_dt"][l, d],
                                                   P["s5_b_re"][l, d], P["s5_b_im"][l, d])
        init = None if h0 is None else (h0[:, d, ..., 0].astype(F32), h0[:, d, ..., 1].astype(F32))
        hr, hi = s5_scan(ug, ab_re, ab_im, bb_re, bb_im, init, reverse=(d == 1))
        c_re, c_im = P["s5_c_re"][l, d].astype(F32), P["s5_c_im"][l, d].astype(F32)
        y = y + (jnp.einsum("ghp,blgp->blgh", c_re, hr)
                 - jnp.einsum("ghp,blgp->blgh", c_im, hi)).reshape(B, L, BRANCH)
        if h0 is None:
            t = L - 1 if d == 0 else 0
            finals.append(jnp.stack([hr[:, t], hi[:, t]], axis=-1))
    glu = jax.nn.gelu(y) @ P["s5_w_glu"][l].astype(F32)
    out = glu[..., :BRANCH] * jax.nn.sigmoid(glu[..., BRANCH:]) * jax.nn.silu(gate.astype(F32))
    state = jnp.stack(finals, axis=1) if h0 is None else None
    return out.astype(u.dtype), state


def hgrn_chunkwise(q, k, v, g, s0):
    B, L, H, _ = q.shape
    n = L // HG_CHUNK

    def chunks(t):
        return jnp.moveaxis(t.reshape(B, n, HG_CHUNK, H, t.shape[-1]), 1, 0)

    causal = jnp.tril(jnp.ones((HG_CHUNK, HG_CHUNK), dtype=bool))[None, :, :, None, None]

    def step(S, inp):
        qc, kc, vc, gc = inp
        b = jnp.cumsum(gc, axis=1)
        decay = jnp.exp(jnp.where(causal, b[:, :, None] - b[:, None, :], -jnp.inf))
        scores = jnp.einsum("bthd,btshd,bshd->bhts", qc, decay, kc)
        o = (jnp.einsum("bhts,bshv->bthv", scores, vc)
             + jnp.einsum("bthd,bhdv->bthv", qc * jnp.exp(b), S))
        b_last = b[:, -1]
        S = S * jnp.exp(b_last)[..., None] + jnp.einsum("bshd,bshv->bhdv", kc * jnp.exp(b_last[:, None] - b), vc)
        return S, o

    S, o = lax.scan(step, s0, (chunks(q), chunks(k), chunks(v), chunks(g)))
    return jnp.moveaxis(o, 0, 1).reshape(B, L, H, v.shape[-1]), S


def hgrn_branch(q, ff, fb, iv, gate, lb_l, norm_g, s0):
    B, L, _ = q.shape
    shp = (B, L, HG_HEADS, HG_DK)
    qf = q.astype(F32).reshape(shp)
    vf = iv.astype(F32).reshape(B, L, HG_HEADS, HG_DV)
    o, finals = None, []
    for d, zf in enumerate((ff, fb)):
        lb = lb_l[d].reshape(HG_HEADS, HG_DK)
        z = zf.astype(F32).reshape(shp)
        log_f = jnp.log(lb + (1.0 - lb) * jax.nn.sigmoid(z))
        k = (1.0 - lb) * jax.nn.sigmoid(-z)
        init = jnp.zeros((B, HG_HEADS, HG_DK, HG_DV), F32) if s0 is None else s0[:, d].astype(F32)
        if d == 0:
            od, Sd = hgrn_chunkwise(qf, k, vf, log_f, init)
        else:
            od, Sd = hgrn_chunkwise(jnp.flip(qf, 1), jnp.flip(k, 1), jnp.flip(vf, 1), jnp.flip(log_f, 1), init)
            od = jnp.flip(od, 1)
        o = od if o is None else o + od
        finals.append(Sd)
    o = rms_norm(o) * norm_g.astype(F32)
    out = o.reshape(B, L, BRANCH) * jax.nn.silu(gate.astype(F32))
    state = jnp.stack(finals, axis=1) if s0 is None else None
    return out.astype(q.dtype), state


def mla_branch(cq, ckv, kr, gate, P, l, pos, ctx):
    B, L, _ = cq.shape
    dt = cq.dtype
    q = (rms_norm(cq) * P["mla_q_norm"][l].astype(F32)).astype(dt) @ P["mla_w_uq"][l]
    q = q.reshape(B, L, MLA_HEADS, MLA_NOPE + MLA_ROPE)
    ckv_n = (rms_norm(ckv) * P["mla_kv_norm"][l].astype(F32)).astype(dt)
    if ctx is None:
        ckv_all, kr_all = ckv_n, kr
    else:
        q = jnp.concatenate([q[..., :MLA_NOPE], rope_2d(q[..., MLA_NOPE:], *pos)], axis=-1)
        kr_lat = rope_2d(kr[:, :, None, :], *pos)[:, :, 0]
        ckv_all = jnp.concatenate([ckv_n, ctx[0].astype(dt)], axis=1)
        kr_all = jnp.concatenate([kr_lat, ctx[1].astype(dt)], axis=1)
    Lk = ckv_all.shape[1]
    kv = (ckv_all @ P["mla_w_ukv"][l]).reshape(B, Lk, MLA_HEADS, MLA_NOPE + MLA_V)
    k = jnp.concatenate([kv[..., :MLA_NOPE],
                         jnp.broadcast_to(kr_all[:, :, None, :], (B, Lk, MLA_HEADS, MLA_ROPE))], axis=-1)
    o = blocked_attention(q, k, kv[..., MLA_NOPE:], (MLA_NOPE + MLA_ROPE) ** -0.5)
    out = o.reshape(B, L, BRANCH).astype(F32) * jax.nn.silu(gate.astype(F32))
    return out.astype(dt), (ckv_n, kr)


def trunk_layer(x, mod, P, l, pos, ctx):
    dt = x.dtype
    shift, scale, gate = jnp.split(mod.astype(F32), 3, axis=-1)
    h = (rms_norm(x) * (1.0 + scale) + shift).astype(dt)
    (da_q, da_k, da_v, da_g, s5_u, s5_g, hg_q, hg_ff, hg_fb, hg_i, hg_g,
     mla_cq, mla_ckv, mla_kr, mla_g) = split_columns(h @ P["w_in"][l])
    latent = ctx is not None
    lam_init = 0.8 - 0.6 * math.exp(-0.3 * l)
    a_out, a_ctx = diff_attn_branch(da_q, da_k, da_v, da_g, P["da_lambda"][l], P["da_norm"][l], lam_init,
                                    pos, ctx[0:2] if latent else None)
    b_out, b_ctx = s5_branch(s5_u, s5_g, P, l, ctx[2] if latent else None)
    c_out, c_ctx = hgrn_branch(hg_q, hg_ff, hg_fb, hg_i, hg_g, P["hg_lb"][l], P["hg_norm"][l],
                               ctx[3] if latent else None)
    d_out, d_ctx = mla_branch(mla_cq, mla_ckv, mla_kr, mla_g, P, l, pos, ctx[4:6] if latent else None)
    mixed = jnp.concatenate([a_out, b_out, c_out, d_out], axis=-1)
    x = (x.astype(F32) + gate * (mixed @ P["w_out"][l]).astype(F32)).astype(dt)
    if latent:
        return x, None
    return x, (a_ctx[0], a_ctx[1], b_ctx, c_ctx, d_ctx[0], d_ctx[1])


def setup_inputs(seed: int = 0) -> dict:
    key = jax.random.key(seed)
    keys = iter(jax.random.split(key, 48))

    def nrm(shape, s=1.0):
        return jax.random.normal(next(keys), shape, F32) * s

    def gain(shape):
        return 1.0 + nrm(shape, 0.02)

    L, G, N, H = DEPTH, S5_GROUPS, S5_STATE, S5_CH
    s5_n = jnp.arange(N, dtype=F32)
    return {
        "x_prompt": nrm((BATCH, SEQ, D_MODEL)),
        "x_sample": nrm((DEC_BATCH, DEC_SEQ, D_MODEL)),
        "cache_diff_k": nrm((DEC_BATCH, DEPTH, PAST_LEN, DA_HEADS, 2 * DA_QK)),
        "cache_diff_v": nrm((DEC_BATCH, DEPTH, PAST_LEN, DA_HEADS, DA_V)),
        "state_s5": nrm((DEC_BATCH, DEPTH, 2, G, N, 2), 0.3),
        "state_hgrn": nrm((DEC_BATCH, DEPTH, 2, HG_HEADS, HG_DK, HG_DV), 0.5),
        "cache_mla_ckv": nrm((DEC_BATCH, DEPTH, PAST_LEN, MLA_KV_RANK)),
        "cache_mla_krope": nrm((DEC_BATCH, DEPTH, PAST_LEN, MLA_ROPE)),
        "c": nrm((DEC_BATCH, D_MODEL)),
        "c_ctx": nrm((D_MODEL,)),
        "w_mod": nrm((L, D_MODEL, 3 * D_MODEL), 0.5 * D_MODEL ** -0.5),
        "b_mod": nrm((L, 3 * D_MODEL), 0.02),
        "w_in": nrm((L, D_MODEL, IN_WIDTH), D_MODEL ** -0.5),
        "w_out": nrm((L, MIX_WIDTH, D_MODEL), MIX_WIDTH ** -0.5),
        "da_lambda": nrm((L, 4, DA_QK), 0.1),
        "da_norm": gain((L, DA_V)),
        "s5_a_re": -0.5 + nrm((L, 2, G, N), 0.01),
        "s5_a_im": math.pi * s5_n + nrm((L, 2, G, N), 0.01),
        "s5_log_dt": jax.random.uniform(next(keys), (L, 2, G), F32, math.log(S5_DT_MIN), math.log(S5_DT_MAX)),
        "s5_b_re": nrm((L, 2, G, N, H), H ** -0.5),
        "s5_b_im": nrm((L, 2, G, N, H), H ** -0.5),
        "s5_c_re": nrm((L, 2, G, H, N), N ** -0.5),
        "s5_c_im": nrm((L, 2, G, H, N), N ** -0.5),
        "s5_d": nrm((L, BRANCH)),
        "s5_w_glu": nrm((L, BRANCH, 2 * BRANCH), BRANCH ** -0.5),
        "hg_lb": nrm((L, 2, HG_HEADS * HG_DK), 0.1),
        "hg_norm": gain((L, HG_DV)),
        "mla_q_norm": gain((L, MLA_Q_RANK)),
        "mla_w_uq": nrm((L, MLA_Q_RANK, MLA_HEADS * (MLA_NOPE + MLA_ROPE)), MLA_Q_RANK ** -0.5),
        "mla_kv_norm": gain((L, MLA_KV_RANK)),
        "mla_w_ukv": nrm((L, MLA_KV_RANK, MLA_HEADS * (MLA_NOPE + MLA_V)), MLA_KV_RANK ** -0.5),
        "final_norm": gain((D_MODEL,)),
    }


def reference(x_prompt, x_sample, cache_diff_k, cache_diff_v, state_s5, state_hgrn, cache_mla_ckv,
              cache_mla_krope, c, c_ctx, w_mod, b_mod, w_in, w_out, da_lambda, da_norm, s5_a_re, s5_a_im,
              s5_log_dt, s5_b_re, s5_b_im, s5_c_re, s5_c_im, s5_d, s5_w_glu, hg_lb, hg_norm, mla_q_norm,
              mla_w_uq, mla_kv_norm, mla_w_ukv, final_norm):
    lb_w = jax.nn.softmax(hg_lb.astype(F32), axis=0)
    lb_all = jnp.cumsum(lb_w, axis=0) - lb_w[0:1]
    P = {
        "w_in": w_in, "w_out": w_out, "da_lambda": da_lambda, "da_norm": da_norm,
        "s5_a_re": s5_a_re, "s5_a_im": s5_a_im, "s5_log_dt": s5_log_dt, "s5_b_re": s5_b_re,
        "s5_b_im": s5_b_im, "s5_c_re": s5_c_re, "s5_c_im": s5_c_im, "s5_d": s5_d, "s5_w_glu": s5_w_glu,
        "hg_lb": lb_all, "hg_norm": hg_norm, "mla_q_norm": mla_q_norm, "mla_w_uq": mla_w_uq,
        "mla_kv_norm": mla_kv_norm, "mla_w_ukv": mla_w_ukv,
    }

    x = x_prompt
    ctx_layers = []
    for l in range(DEPTH):
        mod = (jax.nn.silu(c_ctx.astype(F32)) @ w_mod[l].astype(F32) + b_mod[l].astype(F32))[None, None]
        x, st = trunk_layer(x, mod, P, l, None, None)
        ctx_layers.append(st)
    y_prompt = (rms_norm(x) * final_norm.astype(F32)).astype(x_prompt.dtype)
    new_diff_k = jnp.stack([s[0] for s in ctx_layers], axis=1)
    new_diff_v = jnp.stack([s[1] for s in ctx_layers], axis=1)
    new_s5 = jnp.stack([s[2] for s in ctx_layers], axis=1)
    new_hgrn = jnp.stack([s[3] for s in ctx_layers], axis=1)
    new_mla_ckv = jnp.stack([s[4] for s in ctx_layers], axis=1)
    new_mla_krope = jnp.stack([s[5] for s in ctx_layers], axis=1)

    n_rows = x_sample.shape[1] // GRID_W
    row = jnp.repeat(jnp.arange(n_rows, dtype=jnp.int32), GRID_W)
    col = jnp.tile(jnp.arange(GRID_W, dtype=jnp.int32), n_rows)
    x = x_sample
    for l in range(DEPTH):
        mod = (jax.nn.silu(c.astype(F32)) @ w_mod[l].astype(F32) + b_mod[l].astype(F32))[:, None]
        ctx = (cache_diff_k[:, l], cache_diff_v[:, l], state_s5[:, l], state_hgrn[:, l],
               cache_mla_ckv[:, l], cache_mla_krope[:, l])
        x, _ = trunk_layer(x, mod, P, l, (row, col), ctx)
    y_sample = (rms_norm(x) * final_norm.astype(F32)).astype(x_sample.dtype)

    return (y_prompt, y_sample, new_diff_k, new_diff_v, new_s5, new_hgrn, new_mla_ckv, new_mla_krope)
```

```cpp
#include <hip/hip_runtime.h>
#include <hip/hip_cooperative_groups.h>
#include <stdint.h>
#include <stdio.h>
namespace cg = cooperative_groups;

typedef unsigned short bf16_t;
using bf16x8 = __attribute__((ext_vector_type(8))) short;
using f32x4 = __attribute__((ext_vector_type(4))) float;
using f32x16 = __attribute__((ext_vector_type(16))) float;
#define DEV __device__ __forceinline__

constexpr int NTOK = 8192, NCTX = 4096, ZW = 3456, INW = 3424, KROWS = 8704;
constexpr int Z_DAQ = 0, Z_DAK = 256, Z_DAV = 512, Z_DAG = 768, Z_S5U = 1024, Z_S5G = 1280, Z_HGQ = 1536, Z_HGFF = 1792,
              Z_HGFB = 2048, Z_HGI = 2304, Z_HGG = 2560, Z_CQ = 2816, Z_CKV = 3008, Z_KR = 3136, Z_MLAG = 3168;
constexpr size_t O_YP = 0, O_DK = 8388608, O_DV = 10485760, O_S5 = 12582912, O_HG = 12713984, O_CKV = 13762560, O_KR = 14811136;
constexpr float EPS = 1e-6f;

constexpr size_t al256(size_t x) { return (x + 255) & ~(size_t)255; }
constexpr size_t WS_WIN = 0;
constexpr size_t WS_WOUT = WS_WIN + (size_t)2 * ZW * 1024 * 2;
constexpr size_t WS_WGLU = WS_WOUT + (size_t)2 * 1024 * 1024 * 2;
constexpr size_t WS_WUQ = WS_WGLU + (size_t)2 * 512 * 256 * 2;
constexpr size_t WS_WUKV = WS_WUQ + (size_t)2 * 384 * 192 * 2;
constexpr size_t WS_MODP = WS_WUKV + (size_t)2 * 512 * 128 * 2;
constexpr size_t WS_ROPE = WS_MODP + (size_t)4 * 2 * 3 * 3072 * 4;
constexpr size_t WS_LAM = WS_ROPE + 4096;
constexpr size_t WS_H = WS_LAM + 256;
constexpr size_t WS_Z = WS_H + (size_t)NTOK * 1024 * 2;
constexpr size_t WS_KD = WS_Z + (size_t)NTOK * ZW * 4;
constexpr size_t WS_VDT = WS_KD + (size_t)KROWS * 256 * 2;
constexpr size_t VT_ELEMS = (size_t)16 * 4 * 64 * 256 + (size_t)2 * 4 * 64 * 2304;
constexpr size_t WS_KMLA = WS_VDT + VT_ELEMS * 2;
constexpr size_t WS_VMT = WS_KMLA + (size_t)KROWS * 384 * 2;
constexpr size_t WS_CQN = WS_VMT + VT_ELEMS * 2;
constexpr size_t WS_CKVN = WS_CQN + (size_t)NTOK * 192 * 2;
constexpr size_t WS_QRAW = WS_CKVN + (size_t)KROWS * 128 * 2;
constexpr size_t WS_S5F = WS_QRAW + (size_t)NTOK * 384 * 4;
constexpr size_t WS_HGS = WS_S5F + (size_t)128 * 2 * 16 * 64 * 2 * 4;
constexpr size_t WS_HGD = WS_HGS + (size_t)1024 * 4096 * 4;
constexpr size_t WS_GY = WS_HGD + (size_t)1024 * 64 * 4;
constexpr size_t WS_X1 = WS_GY + (size_t)NTOK * 256 * 2;
constexpr size_t WS_END = WS_X1 + (size_t)NTOK * 1024 * 4;
constexpr size_t WS_BAR = WS_END;
constexpr size_t WS_YP = WS_BAR + 16384;
constexpr size_t WS_KROPE = WS_YP + (size_t)NTOK * 256 * 4;
constexpr size_t WS_BIAS = WS_KROPE + (size_t)KROWS * 32 * 2;
constexpr size_t WS_SSQ = WS_BIAS + (size_t)3 * ZW * 4;
constexpr size_t WS_MODS = WS_SSQ + (size_t)16 * NTOK * 4;
constexpr size_t WS_TOTAL = WS_MODS + (size_t)2 * 3 * 3072 * 4;
static_assert(WS_TOTAL <= (size_t)256 * 1024 * 1024, "workspace too large");

#ifndef REP_AH
#define REP_AH 1
#endif
#ifndef REP_HGB
#define REP_HGB 1
#endif
#ifndef REP_S5B
#define REP_S5B 1
#endif
#ifndef REP_AL
#define REP_AL 1
#endif
#ifndef REP_PREP
#define REP_PREP 1
#endif
#ifndef REP_HGA
#define REP_HGA 1
#endif
#ifndef REP_S5A
#define REP_S5A 1
#endif
#ifndef REP_X2
#define REP_X2 1
#endif
#ifndef REP_P0
#define REP_P0 1
#endif
#ifndef REP_P1
#define REP_P1 1
#endif
#ifndef REP_X1
#define REP_X1 1
#endif
#ifndef REP_X3
#define REP_X3 1
#endif
#ifndef REP_X4
#define REP_X4 1
#endif
#ifndef REP_P3
#define REP_P3 1
#endif
#ifndef REP_SYNC
#define REP_SYNC 0
#endif
constexpr int SMEM_WORK = 2 * 2 * 128 * 72 * 2;
constexpr int SMEM_BYTES = SMEM_WORK + 16;

struct P {
    const float *x_prompt, *x_sample, *cdk, *cdv, *st_s5, *st_hg, *cckv, *ckrope, *c, *c_ctx, *w_mod, *b_mod, *w_in, *w_out,
        *da_lambda, *da_norm, *s5_a_re, *s5_a_im, *s5_log_dt, *s5_b_re, *s5_b_im, *s5_c_re, *s5_c_im, *s5_d, *s5_w_glu, *hg_lb,
        *hg_norm, *mla_q_norm, *mla_w_uq, *mla_kv_norm, *mla_w_ukv, *final_norm;
    float* out;
    char* ws;
};

DEV int ltid() { int t = threadIdx.x; asm volatile("" : "+v"(t)); return t; }
typedef __bf16 bf2_t __attribute__((ext_vector_type(2)));
typedef float f2_t __attribute__((ext_vector_type(2)));
DEV uint32_t pack2(float a, float b) {
    f2_t v = {a, b};
    bf2_t r = __builtin_convertvector(v, bf2_t);
    uint32_t u;
    __builtin_memcpy(&u, &r, 4);
    return u;
}
DEV bf16_t f2bf(float f) { return (bf16_t)(pack2(f, 0.f) & 0xffffu); }
DEV float siluf(float x) { return x / (1.f + __expf(-x)); }
DEV float sigmf(float x) { return 1.f / (1.f + __expf(-x)); }
DEV float geluf(float x) {
    float a = 0.7978845608028654f * (x + 0.044715f * x * x * x);
    float t = 1.f - 2.f / (__expf(2.f * a) + 1.f);
    return 0.5f * x * (1.f + t);
}
DEV float wave_sum(float v) {
#pragma unroll
    for (int o = 32; o >= 1; o >>= 1) v += __shfl_xor(v, o);
    return v;
}
DEV int tok_seq(int tok) { return tok < NCTX ? (tok >> 8) : 16 + ((tok - NCTX) >> 11); }
DEV int tok_cond(int tok) { return tok < NCTX ? 0 : 1 + ((tok - NCTX) >> 11); }
DEV int seq_tok0(int seq) { return seq < 16 ? seq * 256 : NCTX + (seq - 16) * 2048; }
DEV int seq_kr0(int seq) { return seq < 16 ? seq * 256 : NCTX + (seq - 16) * 2304; }
DEV int seq_lk(int seq) { return seq < 16 ? 256 : 2304; }
DEV size_t seq_vt0(int seq) { return seq < 16 ? (size_t)seq * 65536 : (size_t)1048576 + (size_t)(seq - 16) * 589824; }
DEV float mod_val(const float* modp, int l, int cond, int j) {
    float s = 0.f;
#pragma unroll
    for (int q = 0; q < 4; ++q) s += modp[((q * 2 + l) * 3 + cond) * 3072 + j];
    return s;
}

DEV void transpose_tile(const float* __restrict__ src, int K, int Nsrc, bf16_t* __restrict__ dst, int k0, int n0, int mode, float* tile) {
    int tid = ltid(), tx = tid & 63, ty = tid >> 6;
    int n = n0 + tx;
    int sc = (mode == 0) ? (n < Nsrc ? n : -1) : (((n >> 4) & 1) * 256 + (n >> 5) * 16 + (n & 15));
#pragma unroll 4
    for (int i = 0; i < 16; ++i) {
        int k = ty + 4 * i;
        tile[k * 65 + tx] = sc >= 0 ? src[(size_t)(k0 + k) * Nsrc + sc] : 0.f;
    }
    __syncthreads();
    int nl = tid >> 2, kq = tid & 3;
    uint32_t w[8];
#pragma unroll
    for (int j = 0; j < 8; ++j) w[j] = pack2(tile[(kq * 16 + 2 * j) * 65 + nl], tile[(kq * 16 + 2 * j + 1) * 65 + nl]);
    uint4* d = (uint4*)(dst + (size_t)(n0 + nl) * K + k0 + kq * 16);
    d[0] = make_uint4(w[0], w[1], w[2], w[3]);
    d[1] = make_uint4(w[4], w[5], w[6], w[7]);
    __syncthreads();
}

DEV void phase0(const P& p, char* smem, int part) {
    float* tile = (float*)smem;
    bf16_t* WinT = (bf16_t*)(p.ws + WS_WIN);
    bf16_t* WoutT = (bf16_t*)(p.ws + WS_WOUT);
    bf16_t* WgluT = (bf16_t*)(p.ws + WS_WGLU);
    bf16_t* WuqT = (bf16_t*)(p.ws + WS_WUQ);
    bf16_t* WukvT = (bf16_t*)(p.ws + WS_WUKV);
    float* modp = (float*)(p.ws + WS_MODP);
    constexpr int T_IN = 16 * 54, T_OUT = 16 * 16, T_GLU = 4 * 8, T_UQ = 3 * 6, T_UKV = 2 * 8;
    constexpr int T_L = T_IN + T_OUT + T_GLU + T_UQ + T_UKV;
    constexpr int N_MOD = 2 * 48 * 4;
    constexpr int TOTAL = N_MOD + 1 + 2 * T_L;
    const int it_lo = part == 0 ? 0 : N_MOD + 1, it_hi = part == 0 ? N_MOD + 1 : TOTAL;
    for (int it = it_lo + blockIdx.x; it < it_hi; it += gridDim.x) {
        if (it < N_MOD) {
            int l = it / 192, rem = it % 192, cb = rem >> 2, kq = rem & 3;
            int tid = ltid(), cl = tid & 63, kg = tid >> 6, col = cb * 64 + cl, kb = kq * 256 + kg * 64;
            float a0 = 0.f, a1 = 0.f, a2 = 0.f;
            const float* w = p.w_mod + ((size_t)l * 1024 + kb) * 3072 + col;
#pragma unroll 4
            for (int k = 0; k < 64; ++k) {
                float wv = w[(size_t)k * 3072];
                a0 += siluf(p.c_ctx[kb + k]) * wv;
                a1 += siluf(p.c[kb + k]) * wv;
                a2 += siluf(p.c[1024 + kb + k]) * wv;
            }
            tile[(0 * 4 + kg) * 64 + cl] = a0;
            tile[(1 * 4 + kg) * 64 + cl] = a1;
            tile[(2 * 4 + kg) * 64 + cl] = a2;
            __syncthreads();
            if (tid < 192) {
                int cond = tid >> 6;
                float s = tile[(cond * 4 + 0) * 64 + cl] + tile[(cond * 4 + 1) * 64 + cl] + tile[(cond * 4 + 2) * 64 + cl] + tile[(cond * 4 + 3) * 64 + cl];
                if (kq == 0) s += p.b_mod[l * 3072 + col];
                modp[((kq * 2 + l) * 3 + cond) * 3072 + col] = s;
            }
            __syncthreads();
        } else if (it == N_MOD) {
            float* tab = (float*)(p.ws + WS_ROPE);
            float* lam = (float*)(p.ws + WS_LAM);
            for (int e = ltid(); e < 512; e += 256) {
                int pos = e >> 3, f = e & 7;
                float inv = powf(10000.f, -(float)f / 8.f);
                float ang = (float)pos * inv;
                tab[e * 2] = cosf(ang);
                tab[e * 2 + 1] = sinf(ang);
            }
            if (ltid() < 2) {
                int l = ltid();
                const float* lv = p.da_lambda + l * 128;
                float s1 = 0.f, s2 = 0.f;
                for (int i = 0; i < 32; ++i) { s1 += lv[i] * lv[32 + i]; s2 += lv[64 + i] * lv[96 + i]; }
                float li = 0.8f - 0.6f * expf(-0.3f * (float)l);
                lam[l] = expf(s1) - expf(s2) + li;
                lam[2 + l] = li;
            }
        } else {
            int j = it - N_MOD - 1, l = j / T_L, r = j % T_L;
            if (r < T_IN) {
                transpose_tile(p.w_in + (size_t)l * 1024 * INW, 1024, INW, WinT + (size_t)l * ZW * 1024, (r / 54) * 64, (r % 54) * 64, 0, tile);
            } else if ((r -= T_IN) < T_OUT) {
                transpose_tile(p.w_out + (size_t)l * 1024 * 1024, 1024, 1024, WoutT + (size_t)l * 1024 * 1024, (r / 16) * 64, (r % 16) * 64, 0, tile);
            } else if ((r -= T_OUT) < T_GLU) {
                transpose_tile(p.s5_w_glu + (size_t)l * 256 * 512, 256, 512, WgluT + (size_t)l * 512 * 256, (r / 8) * 64, (r % 8) * 64, 1, tile);
            } else if ((r -= T_GLU) < T_UQ) {
                transpose_tile(p.mla_w_uq + (size_t)l * 192 * 384, 192, 384, WuqT + (size_t)l * 384 * 192, (r / 6) * 64, (r % 6) * 64, 0, tile);
            } else {
                r -= T_UQ;
                transpose_tile(p.mla_w_ukv + (size_t)l * 128 * 512, 128, 512, WukvT + (size_t)l * 512 * 128, (r / 8) * 64, (r % 8) * 64, 0, tile);
            }
        }
    }
}

DEV void bias_block(const P& p, int item, char* smem) {
    float* sh = (float*)smem;
    float* red = sh + 3 * 1024;
    const float* modp = (const float*)(p.ws + WS_MODP);
    const int tid = ltid(), cl = tid & 63, kg = tid >> 6, col = item * 64 + cl;
    __syncthreads();
    for (int idx = tid; idx < 3072; idx += 256) sh[idx] = mod_val(modp, 1, idx >> 10, idx & 1023);
    __syncthreads();
    float a0 = 0.f, a1 = 0.f, a2 = 0.f;
    if (col < INW) {
        const float* w = p.w_in + ((size_t)1024 + kg * 256) * INW + col;
#pragma unroll 8
        for (int k = 0; k < 256; ++k) {
            const float wv = w[(size_t)k * INW];
            a0 += sh[kg * 256 + k] * wv; a1 += sh[1024 + kg * 256 + k] * wv; a2 += sh[2048 + kg * 256 + k] * wv;
        }
    }
    red[(0 * 4 + kg) * 64 + cl] = a0; red[(1 * 4 + kg) * 64 + cl] = a1; red[(2 * 4 + kg) * 64 + cl] = a2;
    __syncthreads();
    if (tid < 192) {
        const int c = tid >> 6;
        ((float*)(p.ws + WS_BIAS))[c * ZW + item * 64 + cl] =
            red[(c * 4 + 0) * 64 + cl] + red[(c * 4 + 1) * 64 + cl] + red[(c * 4 + 2) * 64 + cl] + red[(c * 4 + 3) * 64 + cl];
    }
    __syncthreads();
}

DEV void phase_rownorm(const P& p, int l, int final_mode) {
    const float* modp = (const float*)(p.ws + WS_MODP);
    bf16_t* h = (bf16_t*)(p.ws + WS_H);
    int lane = ltid() & 63, wave = ltid() >> 6;
    for (int row = blockIdx.x * 4 + wave; row < NTOK; row += gridDim.x * 4) {
        const float* src;
        if (final_mode) src = row < NCTX ? (const float*)(p.ws + WS_H) + (size_t)row * 1024 : (const float*)(p.ws + WS_HGS) + (size_t)(row - NCTX) * 1024;
        else if (l == 0) src = row < NCTX ? p.x_prompt + (size_t)row * 1024 : p.x_sample + (size_t)(row - NCTX) * 1024;
        else src = (const float*)(p.ws + WS_X1) + (size_t)row * 1024;
        float4 v[4];
        float ss = 0.f;
#pragma unroll
        for (int i = 0; i < 4; ++i) {
            v[i] = ((const float4*)src)[lane + 64 * i];
            ss += v[i].x * v[i].x + v[i].y * v[i].y + v[i].z * v[i].z + v[i].w * v[i].w;
        }
        ss = wave_sum(ss);
        float rstd = rsqrtf(ss * (1.f / 1024.f) + EPS);
        if (final_mode) {
#pragma unroll
            for (int i = 0; i < 4; ++i) {
                int j = (lane + 64 * i) * 4;
                float4 g = *(const float4*)(p.final_norm + j);
                float4 o = make_float4(v[i].x * rstd * g.x, v[i].y * rstd * g.y, v[i].z * rstd * g.z, v[i].w * rstd * g.w);
                *(float4*)(p.out + O_YP + (size_t)row * 1024 + j) = o;
            }
        } else {
            int cond = tok_cond(row);
#pragma unroll
            for (int i = 0; i < 4; ++i) {
                int j = (lane + 64 * i) * 4;
                float sh[4], sc[4];
#pragma unroll
                for (int e = 0; e < 4; ++e) { sh[e] = mod_val(modp, l, cond, j + e); sc[e] = mod_val(modp, l, cond, 1024 + j + e); }
                float o0 = v[i].x * rstd * (1.f + sc[0]) + sh[0], o1 = v[i].y * rstd * (1.f + sc[1]) + sh[1];
                float o2 = v[i].z * rstd * (1.f + sc[2]) + sh[2], o3 = v[i].w * rstd * (1.f + sc[3]) + sh[3];
                *(uint2*)(h + (size_t)row * 1024 + j) = make_uint2(pack2(o0, o1), pack2(o2, o3));
            }
        }
    }
}

enum { EPI_INPROJ = 0, EPI_UQ = 1, EPI_UKV = 2, EPI_GLU = 3, EPI_OUT = 4 };

template <int EPI>
DEV void gemm_tile(const P& p, int l, const bf16_t* __restrict__ A, int lda, const bf16_t* __restrict__ Bt, int ldb, int K, int m0, int n0, char* smem) {
    char* As = smem;
    char* Bs = smem + 2 * 16384;
    const int tid = ltid(), lane = tid & 63, wave = tid >> 6, wr = wave >> 1, wc = wave & 1;
    f32x4 acc[4][4];
#pragma unroll
    for (int i = 0; i < 4; ++i)
#pragma unroll
        for (int j = 0; j < 4; ++j) acc[i][j] = f32x4{0.f, 0.f, 0.f, 0.f};
    const int srow = wave * 8 + (lane >> 3), schunk = (lane & 7) ^ ((lane >> 3) & 7);
    const bf16_t* Ag = A + (size_t)(m0 + srow) * lda + schunk * 8;
    const bf16_t* Bg = Bt + (size_t)(n0 + srow) * ldb + schunk * 8;
#define G_DMA(buf_, kt_)                                                                                                              \
    {                                                                                                                                 \
        _Pragma("unroll") for (int i = 0; i < 4; ++i) {                                                                               \
            __builtin_amdgcn_global_load_lds((const unsigned*)(Ag + (size_t)(32 * i) * lda + (kt_) * 64),                             \
                                             (unsigned*)(As + (buf_) * 16384 + wave * 1024 + i * 4096), 16, 0, 0);                    \
            __builtin_amdgcn_global_load_lds((const unsigned*)(Bg + (size_t)(32 * i) * ldb + (kt_) * 64),                             \
                                             (unsigned*)(Bs + (buf_) * 16384 + wave * 1024 + i * 4096), 16, 0, 0);                    \
        }                                                                                                                             \
    }
    const int fr = lane & 15, fq = lane >> 4;
    const int nk = K >> 6;
    G_DMA(0, 0)
    __syncthreads();
    for (int kt = 0; kt < nk; ++kt) {
        const int cur = kt & 1;
        if (kt + 1 < nk) G_DMA(cur ^ 1, kt + 1)
        const char* Ac = As + cur * 16384 + (wr * 64 + fr) * 128;
        const char* Bc = Bs + cur * 16384 + (wc * 64 + fr) * 128;
#pragma unroll
        for (int kk = 0; kk < 2; ++kk) {
            const int pc = ((kk * 4 + fq) ^ (fr & 7)) * 16;
            bf16x8 af[4], bfr[4];
#pragma unroll
            for (int i = 0; i < 4; ++i) {
                af[i] = *(const bf16x8*)(Ac + i * 16 * 128 + pc);
                bfr[i] = *(const bf16x8*)(Bc + i * 16 * 128 + pc);
            }
#pragma unroll
            for (int i = 0; i < 4; ++i)
#pragma unroll
                for (int j = 0; j < 4; ++j) acc[i][j] = __builtin_amdgcn_mfma_f32_16x16x32_bf16(bfr[j], af[i], acc[i][j], 0, 0, 0);
        }
        __syncthreads();
    }
#undef G_DMA
    const int rbase = m0 + wr * 64 + (lane & 15);
    const int cbase = n0 + wc * 64 + (lane >> 4) * 4;
    if constexpr (EPI == EPI_INPROJ) {
        float* z = (float*)(p.ws + WS_Z);
        const float* ssq = (const float*)(p.ws + WS_SSQ);
        const float* biasp = (const float*)(p.ws + WS_BIAS) + tok_cond(m0) * ZW;
#pragma unroll
        for (int mi = 0; mi < 4; ++mi) {
            const int row = rbase + mi * 16;
            const int b = row >> 8, t = row & 255;
            const size_t bt = (size_t)((b * 2 + l) * 256 + t);
            float rs = 1.f;
            if (l == 1) {
                float ssum = 0.f;
#pragma unroll
                for (int q = 0; q < 16; ++q) ssum += ssq[q * NTOK + row];
                rs = rsqrtf(ssum * (1.f / 1024.f) + EPS);
            }
#pragma unroll
            for (int ni = 0; ni < 4; ++ni) {
                const int col = cbase + ni * 16;
                float4 v = make_float4(acc[mi][ni][0], acc[mi][ni][1], acc[mi][ni][2], acc[mi][ni][3]);
                if (l == 1) {
                    const float4 bb = *(const float4*)(biasp + col);
                    v = make_float4(v.x * rs + bb.x, v.y * rs + bb.y, v.z * rs + bb.z, v.w * rs + bb.w);
                }
                *(float4*)(z + (size_t)row * ZW + col) = v;
                if (row < NCTX) {
                    if (col >= Z_DAK && col < Z_DAV) *(float4*)(p.out + O_DK + bt * 256 + (col - Z_DAK)) = v;
                    else if (col >= Z_DAV && col < Z_DAG) *(float4*)(p.out + O_DV + bt * 256 + (col - Z_DAV)) = v;
                    else if (col >= Z_KR && col < Z_MLAG) *(float4*)(p.out + O_KR + bt * 32 + (col - Z_KR)) = v;
                }
            }
        }
    } else if constexpr (EPI == EPI_UQ) {
        float* q = (float*)(p.ws + WS_QRAW);
#pragma unroll
        for (int mi = 0; mi < 4; ++mi)
#pragma unroll
            for (int ni = 0; ni < 4; ++ni)
                *(float4*)(q + (size_t)(rbase + mi * 16) * 384 + cbase + ni * 16) = make_float4(acc[mi][ni][0], acc[mi][ni][1], acc[mi][ni][2], acc[mi][ni][3]);
    } else if constexpr (EPI == EPI_UKV) {
        bf16_t* Kmla = (bf16_t*)(p.ws + WS_KMLA);
        bf16_t* VmT = (bf16_t*)(p.ws + WS_VMT);
        int seq = m0 < NCTX ? (m0 >> 8) : 16 + (m0 - NCTX) / 2304;
        int kr0 = seq_kr0(seq), lk = seq_lk(seq);
        size_t vt0 = seq_vt0(seq);
#pragma unroll
        for (int ni = 0; ni < 4; ++ni) {
            int col = cbase + ni * 16, hd = col >> 7, j = col & 127;
#pragma unroll
            for (int mi = 0; mi < 4; ++mi) {
                int row = rbase + mi * 16;
                if (j < 64) {
                    *(uint2*)(Kmla + (size_t)row * 384 + hd * 96 + j) = make_uint2(pack2(acc[mi][ni][0], acc[mi][ni][1]), pack2(acc[mi][ni][2], acc[mi][ni][3]));
                } else {
                    int key = row - kr0;
#pragma unroll
                    for (int r = 0; r < 4; ++r) VmT[vt0 + (size_t)(hd * 64 + (j - 64) + r) * lk + key] = f2bf(acc[mi][ni][r]);
                }
            }
        }
    } else if constexpr (EPI == EPI_GLU) {
        const float* z = (const float*)(p.ws + WS_Z);
        bf16_t* mixed = (bf16_t*)(p.out + 4194304);
#pragma unroll
        for (int np = 0; np < 2; ++np) {
            int colp = n0 + wc * 64 + np * 32;
            int j = (colp >> 5) * 16 + (lane >> 4) * 4;
#pragma unroll
            for (int mi = 0; mi < 4; ++mi) {
                int row = rbase + mi * 16;
                float4 gt = *(const float4*)(z + (size_t)row * ZW + Z_S5G + j);
                float y0 = acc[mi][2 * np][0] * sigmf(acc[mi][2 * np + 1][0]) * siluf(gt.x);
                float y1 = acc[mi][2 * np][1] * sigmf(acc[mi][2 * np + 1][1]) * siluf(gt.y);
                float y2 = acc[mi][2 * np][2] * sigmf(acc[mi][2 * np + 1][2]) * siluf(gt.z);
                float y3 = acc[mi][2 * np][3] * sigmf(acc[mi][2 * np + 1][3]) * siluf(gt.w);
                *(uint2*)(mixed + (size_t)row * 1024 + 256 + j) = make_uint2(pack2(y0, y1), pack2(y2, y3));
            }
        }
    } else if constexpr (EPI == EPI_OUT) {
        const float* mods = (const float*)(p.ws + WS_MODS);
        const float* x1 = (const float*)(p.ws + WS_X1);
        int cond = tok_cond(m0);
        float gate[4][4];
#pragma unroll
        for (int ni = 0; ni < 4; ++ni)
#pragma unroll
            for (int r = 0; r < 4; ++r) gate[ni][r] = mods[(l * 3 + cond) * 3072 + 2048 + cbase + ni * 16 + r];
        float sc1[4][4];
#pragma unroll
        for (int ni = 0; ni < 4; ++ni)
#pragma unroll
            for (int r = 0; r < 4; ++r) sc1[ni][r] = (l == 0) ? 1.f + mods[(3 + cond) * 3072 + 1024 + cbase + ni * 16 + r] : 1.f;
#pragma unroll
        for (int mi = 0; mi < 4; ++mi) {
            int row = rbase + mi * 16;
            const float* xp = (l == 0) ? (row < NCTX ? p.x_prompt + (size_t)row * 1024 : p.x_sample + (size_t)(row - NCTX) * 1024)
                                       : x1 + (size_t)row * 1024;
            float* xn = (l == 0) ? (float*)(p.ws + WS_X1) + (size_t)row * 1024
                                 : (row < NCTX ? (float*)(p.ws + WS_H) + (size_t)row * 1024 : (float*)(p.ws + WS_HGS) + (size_t)(row - NCTX) * 1024);
            float sq = 0.f;
#pragma unroll
            for (int ni = 0; ni < 4; ++ni) {
                int col = cbase + ni * 16;
                float4 xv = *(const float4*)(xp + col);
                const float4 xo = make_float4(xv.x + gate[ni][0] * acc[mi][ni][0], xv.y + gate[ni][1] * acc[mi][ni][1],
                                              xv.z + gate[ni][2] * acc[mi][ni][2], xv.w + gate[ni][3] * acc[mi][ni][3]);
                *(float4*)(xn + col) = xo;
                if (l == 0) {
                    sq += xo.x * xo.x + xo.y * xo.y + xo.z * xo.z + xo.w * xo.w;
                    *(uint2*)((bf16_t*)(p.ws + WS_H) + (size_t)row * 1024 + col) =
                        make_uint2(pack2(xo.x * sc1[ni][0], xo.y * sc1[ni][1]), pack2(xo.z * sc1[ni][2], xo.w * sc1[ni][3]));
                }
            }
            if (l == 0) {
                sq += __shfl_xor(sq, 16);
                sq += __shfl_xor(sq, 32);
                if ((lane >> 4) == 0) ((float*)(p.ws + WS_SSQ))[(size_t)((n0 >> 7) * 2 + wc) * NTOK + row] = sq;
            }
        }
    }
}

DEV void prep_chunk(const P& p, int l, int item, char* smem) {
    bf16_t* vbuf = (bf16_t*)smem;
    const float* z = (const float*)(p.ws + WS_Z);
    const float* tab = (const float*)(p.ws + WS_ROPE);
    bf16_t* Kd = (bf16_t*)(p.ws + WS_KD);
    bf16_t* VdT = (bf16_t*)(p.ws + WS_VDT);
    bf16_t* Kmla = (bf16_t*)(p.ws + WS_KMLA);
    bf16_t* cqn = (bf16_t*)(p.ws + WS_CQN);
    bf16_t* ckvn = (bf16_t*)(p.ws + WS_CKVN);
    const int part = item % 3;
    const int r0 = (item / 3) * 64;
    int seq, key0, tokb = 0, cb = 0, p0 = 0;
    bool cached = false, rope = false;
    if (r0 < NCTX) { seq = r0 >> 8; key0 = r0 & 255; tokb = r0; }
    else {
        int rr = r0 - NCTX; cb = rr / 2304; key0 = rr % 2304; seq = 16 + cb;
        if (key0 < 2048) { tokb = NCTX + cb * 2048 + key0; rope = true; }
        else { cached = true; p0 = key0 - 2048; }
    }
    const int lane = ltid() & 63, wave = ltid() >> 6;
#pragma unroll 4
    for (int i = wave; i < 64; i += 4) {
        const int kr = r0 + i;
        const float *dk, *dv, *krs, *ckv, *cq = nullptr;
        if (!cached) {
            const float* zr = z + (size_t)(tokb + i) * ZW;
            dk = zr + Z_DAK; dv = zr + Z_DAV; krs = zr + Z_KR; ckv = zr + Z_CKV; cq = zr + Z_CQ;
        } else {
            size_t bp = (size_t)((cb * 2 + l) * 256 + p0 + i);
            dk = p.cdk + bp * 256; dv = p.cdv + bp * 256; krs = p.ckrope + bp * 32; ckv = p.cckv + bp * 128;
        }
        const int t = key0 + i;
        if (part == 0) {
            float4 x = ((const float4*)dk)[lane];
            float xs[4] = {x.x, x.y, x.z, x.w};
            float px[4];
#pragma unroll
            for (int e = 0; e < 4; ++e) px[e] = __shfl_xor(xs[e], 2);
            if (rope) {
                int sect = (lane & 7) >> 2;
                int pos = sect ? (t & 63) : (t >> 6);
                bool lo = (lane & 3) < 2;
#pragma unroll
                for (int e = 0; e < 4; ++e) {
                    int f = 4 * (lane & 1) + e;
                    float cs = tab[(pos * 8 + f) * 2], sn = tab[(pos * 8 + f) * 2 + 1];
                    xs[e] = lo ? xs[e] * cs - px[e] * sn : px[e] * sn + xs[e] * cs;
                }
            }
            *(uint2*)(Kd + (size_t)kr * 256 + lane * 4) = make_uint2(pack2(xs[0], xs[1]), pack2(xs[2], xs[3]));
        }
        if (part == 1) {
            float4 x = ((const float4*)dv)[lane];
            *(uint2*)(vbuf + i * 260 + lane * 4) = make_uint2(pack2(x.x, x.y), pack2(x.z, x.w));
        }
        if (part == 2) {
            int l8 = lane & 7;
            float4 x = ((const float4*)krs)[l8];
            float xs[4] = {x.x, x.y, x.z, x.w};
            float px[4];
#pragma unroll
            for (int e = 0; e < 4; ++e) px[e] = __shfl_xor(xs[e], 2);
            if (rope) {
                int sect = l8 >> 2;
                int pos = sect ? (t & 63) : (t >> 6);
                bool lo = (l8 & 3) < 2;
#pragma unroll
                for (int e = 0; e < 4; ++e) {
                    int f = 4 * (l8 & 1) + e;
                    float cs = tab[(pos * 8 + f) * 2], sn = tab[(pos * 8 + f) * 2 + 1];
                    xs[e] = lo ? xs[e] * cs - px[e] * sn : px[e] * sn + xs[e] * cs;
                }
            }
            if (lane < 8) *(uint2*)((bf16_t*)(p.ws + WS_KROPE) + (size_t)kr * 32 + l8 * 4) = make_uint2(pack2(xs[0], xs[1]), pack2(xs[2], xs[3]));
        }
        if (part == 2) {
            float4 x = lane < 32 ? ((const float4*)ckv)[lane] : make_float4(0.f, 0.f, 0.f, 0.f);
            float o0 = x.x, o1 = x.y, o2 = x.z, o3 = x.w;
            if (!cached) {
                float ss = wave_sum(x.x * x.x + x.y * x.y + x.z * x.z + x.w * x.w);
                float rstd = rsqrtf(ss * (1.f / 128.f) + EPS);
                if (lane < 32) {
                    float4 g = ((const float4*)(p.mla_kv_norm + l * 128))[lane];
                    o0 = x.x * rstd * g.x; o1 = x.y * rstd * g.y; o2 = x.z * rstd * g.z; o3 = x.w * rstd * g.w;
                    if (r0 < NCTX) {
                        int b = kr >> 8, tt = kr & 255;
                        *(float4*)(p.out + O_CKV + (size_t)((b * 2 + l) * 256 + tt) * 128 + lane * 4) = make_float4(o0, o1, o2, o3);
                    }
                }
            }
            if (lane < 32) *(uint2*)(ckvn + (size_t)kr * 128 + lane * 4) = make_uint2(pack2(o0, o1), pack2(o2, o3));
        }
        if (part == 2 && !cached) {
            float4 x = lane < 48 ? ((const float4*)cq)[lane] : make_float4(0.f, 0.f, 0.f, 0.f);
            float ss = wave_sum(x.x * x.x + x.y * x.y + x.z * x.z + x.w * x.w);
            float rstd = rsqrtf(ss * (1.f / 192.f) + EPS);
            if (lane < 48) {
                float4 g = ((const float4*)(p.mla_q_norm + l * 192))[lane];
                *(uint2*)(cqn + (size_t)(tokb + i) * 192 + lane * 4) =
                    make_uint2(pack2(x.x * rstd * g.x, x.y * rstd * g.y), pack2(x.z * rstd * g.z, x.w * rstd * g.w));
            }
        }
    }
    if (part != 1) return;
    __syncthreads();
    {
        const int c = ltid(), lk = seq_lk(seq);
        bf16_t* dst = VdT + seq_vt0(seq) + (size_t)c * lk + key0;
#pragma unroll
        for (int q = 0; q < 8; ++q) {
            uint32_t w[4];
#pragma unroll
            for (int e = 0; e < 4; ++e) w[e] = (uint32_t)vbuf[(q * 8 + 2 * e) * 260 + c] | ((uint32_t)vbuf[(q * 8 + 2 * e + 1) * 260 + c] << 16);
            *(uint4*)(dst + q * 8) = make_uint4(w[0], w[1], w[2], w[3]);
        }
    }
    __syncthreads();
}

DEV void s5_params(const P& p, int l, int dir, int g, int lane, float& abr, float& abi, float (&bbr)[16], float (&bbi)[16]) {
    const int ldg = (l * 2 + dir) * 16 + g;
    float step = expf(p.s5_log_dt[ldg]);
    float are = p.s5_a_re[ldg * 64 + lane], aim = p.s5_a_im[ldg * 64 + lane];
    float mag = expf(are * step);
    float ang = aim * step;
    abr = mag * cosf(ang);
    abi = mag * sinf(ang);
    float den = are * are + aim * aim;
    float fre = ((abr - 1.f) * are + abi * aim) / den, fim = (abi * are - (abr - 1.f) * aim) / den;
    const float4* br = (const float4*)(p.s5_b_re + (size_t)(ldg * 64 + lane) * 16);
    const float4* bi = (const float4*)(p.s5_b_im + (size_t)(ldg * 64 + lane) * 16);
#pragma unroll
    for (int q = 0; q < 4; ++q) {
        float4 r = br[q], im = bi[q];
        bbr[4 * q + 0] = fre * r.x - fim * im.x; bbi[4 * q + 0] = fre * im.x + fim * r.x;
        bbr[4 * q + 1] = fre * r.y - fim * im.y; bbi[4 * q + 1] = fre * im.y + fim * r.y;
        bbr[4 * q + 2] = fre * r.z - fim * im.z; bbi[4 * q + 2] = fre * im.z + fim * r.z;
        bbr[4 * q + 3] = fre * r.w - fim * im.w; bbi[4 * q + 3] = fre * im.w + fim * r.w;
    }
}
DEV void s5_bu8(const float* ubuf, int sb, int dir, const float (&bbr)[16], const float (&bbi)[16], float (&bur)[8], float (&bui)[8]) {
#pragma unroll
    for (int ii = 0; ii < 8; ++ii) {
        const int i = dir ? 7 - ii : ii;
        const float4* up = (const float4*)(ubuf + (sb * 8 + i) * 16);
        float4 u0 = up[0], u1 = up[1], u2 = up[2], u3 = up[3];
        float r0 = bbr[0] * u0.x, r1 = bbr[1] * u0.y, i0 = bbi[0] * u0.x, i1 = bbi[1] * u0.y;
        r0 += bbr[2] * u0.z; r1 += bbr[3] * u0.w; i0 += bbi[2] * u0.z; i1 += bbi[3] * u0.w;
        r0 += bbr[4] * u1.x; r1 += bbr[5] * u1.y; i0 += bbi[4] * u1.x; i1 += bbi[5] * u1.y;
        r0 += bbr[6] * u1.z; r1 += bbr[7] * u1.w; i0 += bbi[6] * u1.z; i1 += bbi[7] * u1.w;
        r0 += bbr[8] * u2.x; r1 += bbr[9] * u2.y; i0 += bbi[8] * u2.x; i1 += bbi[9] * u2.y;
        r0 += bbr[10] * u2.z; r1 += bbr[11] * u2.w; i0 += bbi[10] * u2.z; i1 += bbi[11] * u2.w;
        r0 += bbr[12] * u3.x; r1 += bbr[13] * u3.y; i0 += bbi[12] * u3.x; i1 += bbi[13] * u3.y;
        r0 += bbr[14] * u3.z; r1 += bbr[15] * u3.w; i0 += bbi[14] * u3.z; i1 += bbi[15] * u3.w;
        bur[ii] = r0 + r1; bui[ii] = i0 + i1;
    }
}
DEV void s5_stage_u(const float* __restrict__ z, int tok0, int g, int lane, float* ubuf) {
    float4 v[4];
#pragma unroll
    for (int k = 0; k < 4; ++k) v[k] = *(const float4*)(z + (size_t)(tok0 + (lane >> 2) + 16 * k) * ZW + Z_S5U + g * 16 + (lane & 3) * 4);
#pragma unroll
    for (int k = 0; k < 4; ++k) *(float4*)(ubuf + ((lane >> 2) + 16 * k) * 16 + (lane & 3) * 4) = v[k];
    __builtin_amdgcn_wave_barrier();
    asm volatile("s_waitcnt lgkmcnt(0)" ::: "memory");
}
DEV void s5a_wave(const P& p, int l, int witem, char* smem_wave) {
    float* ubuf = (float*)smem_wave;
    const int lane = ltid() & 63;
    const int g = witem & 15, dir = (witem >> 4) & 1, gc = witem >> 5;
    float abr, abi, bbr[16], bbi[16];
    s5_params(p, l, dir, g, lane, abr, abi, bbr, bbi);
    const float* z = (const float*)(p.ws + WS_Z);
    const int tok0 = gc * 64;
    s5_stage_u(z, tok0, g, lane, ubuf);
    float hr = 0.f, hi = 0.f;
#pragma unroll 2
    for (int sbi = 0; sbi < 8; ++sbi) {
        const int sb = dir ? 7 - sbi : sbi;
        float bur[8], bui[8];
        s5_bu8(ubuf, sb, dir, bbr, bbi, bur, bui);
#pragma unroll
        for (int ii = 0; ii < 8; ++ii) {
            float nr = abr * hr - abi * hi + bur[ii], ni = abr * hi + abi * hr + bui[ii];
            hr = nr; hi = ni;
        }
    }
    float2* F = (float2*)(p.ws + WS_S5F);
    F[(size_t)((gc * 2 + dir) * 16 + g) * 64 + lane] = make_float2(hr, hi);
    __builtin_amdgcn_wave_barrier();
}
constexpr int S5H = 132;
constexpr int S5B_LDS = (64 * 16 + 16 * S5H) * 4;
DEV void s5_split8(const float4 a, const float4 b, bf16x8& hi, bf16x8& lo) {
    const float x[8] = {a.x, a.y, a.z, a.w, b.x, b.y, b.z, b.w};
    union { bf16x8 v; uint32_t u[4]; } H, L;
#pragma unroll
    for (int j = 0; j < 4; ++j) {
        const uint32_t h = pack2(x[2 * j], x[2 * j + 1]);
        const float h0 = __uint_as_float(h << 16), h1 = __uint_as_float(h & 0xffff0000u);
        H.u[j] = h;
        L.u[j] = pack2(x[2 * j] - h0, x[2 * j + 1] - h1);
    }
    hi = H.v; lo = L.v;
}
DEV void s5b_wave(const P& p, int l, int witem, char* smem_wave) {
    float* ubuf = (float*)smem_wave;
    float* hb = ubuf + 64 * 16;
    const int lane = ltid() & 63;
    const int g = witem & 15, gc = witem >> 4;
    const int tok0 = gc * 64;
    const int seq = tok_seq(tok0);
    const int nch = seq < 16 ? 4 : 32;
    const int gcb = seq < 16 ? seq * 4 : 64 + (seq - 16) * 32;
    const int cis = gc - gcb;
    const float* z = (const float*)(p.ws + WS_Z);
    const float2* F = (const float2*)(p.ws + WS_S5F);
    s5_stage_u(z, tok0, g, lane, ubuf);
    float* yp = (float*)(p.ws + WS_YP);
    bf16_t* gy = (bf16_t*)(p.ws + WS_GY);
    const int ch = lane & 15, kg = lane >> 4;
    const float dch = p.s5_d[l * 256 + g * 16 + ch];
#pragma nounroll
    for (int dir = 0; dir < 2; ++dir) {
        float abr, abi, bbr[16], bbi[16];
        s5_params(p, l, dir, g, lane, abr, abi, bbr, bbi);
        float pr = abr, pi = abi;
#pragma unroll
        for (int s = 0; s < 6; ++s) { float nr = pr * pr - pi * pi, ni = 2.f * pr * pi; pr = nr; pi = ni; }
        float hr = 0.f, hi = 0.f;
        if (seq >= 16) {
            const float* h0 = p.st_s5 + ((size_t)((((seq - 16) * 2 + l) * 2 + dir) * 16 + g) * 64 + lane) * 2;
            hr = h0[0]; hi = h0[1];
        }
        const int nprior = dir ? (nch - 1 - cis) : cis;
#pragma unroll 4
        for (int j = 0; j < nprior; ++j) {
            int c = dir ? (nch - 1 - j) : j;
            float2 f = F[(size_t)(((gcb + c) * 2 + dir) * 16 + g) * 64 + lane];
            float nr = pr * hr - pi * hi + f.x, ni = pr * hi + pi * hr + f.y;
            hr = nr; hi = ni;
        }
        bf16x8 chi[4], clo[4];
        {
            const float* cr = p.s5_c_re + (size_t)((l * 2 + dir) * 16 + g) * 16 * 64 + ch * 64;
            const float* ci = p.s5_c_im + (size_t)((l * 2 + dir) * 16 + g) * 16 * 64 + ch * 64;
#pragma unroll
            for (int s = 0; s < 4; ++s) {
                const float* src = (s < 2 ? cr : ci) + 32 * (s & 1) + 8 * kg;
                float4 a = *(const float4*)src, b = *(const float4*)(src + 4);
                if (s >= 2) { a.x = -a.x; a.y = -a.y; a.z = -a.z; a.w = -a.w; b.x = -b.x; b.y = -b.y; b.z = -b.z; b.w = -b.w; }
                s5_split8(a, b, chi[s], clo[s]);
            }
        }
#pragma nounroll
        for (int sbi = 0; sbi < 4; ++sbi) {
            const int sb = dir ? 3 - sbi : sbi;
#pragma nounroll
            for (int half = 0; half < 2; ++half) {
                const int h8 = dir ? 1 - half : half;
                float bur[8], bui[8];
                s5_bu8(ubuf, sb * 2 + h8, dir, bbr, bbi, bur, bui);
#pragma unroll
                for (int ii = 0; ii < 8; ++ii) {
                    const int i = h8 * 8 + (dir ? 7 - ii : ii);
                    float nr = abr * hr - abi * hi + bur[ii], ni = abr * hi + abi * hr + bui[ii];
                    hr = nr; hi = ni;
                    hb[i * S5H + lane] = hr;
                    hb[i * S5H + 64 + lane] = hi;
                }
            }
            __builtin_amdgcn_wave_barrier();
            asm volatile("s_waitcnt lgkmcnt(0)" ::: "memory");
            f32x4 acc = {0.f, 0.f, 0.f, 0.f};
#pragma unroll
            for (int s = 0; s < 4; ++s) {
                const float* hp = hb + (lane & 15) * S5H + 32 * s + 8 * kg;
                bf16x8 ahi, alo;
                s5_split8(*(const float4*)hp, *(const float4*)(hp + 4), ahi, alo);
                acc = __builtin_amdgcn_mfma_f32_16x16x32_bf16(ahi, chi[s], acc, 0, 0, 0);
                acc = __builtin_amdgcn_mfma_f32_16x16x32_bf16(ahi, clo[s], acc, 0, 0, 0);
                acc = __builtin_amdgcn_mfma_f32_16x16x32_bf16(alo, chi[s], acc, 0, 0, 0);
            }
#pragma unroll
            for (int r = 0; r < 4; ++r) {
                const int tl = sb * 16 + kg * 4 + r;
                float* ypp = yp + ((size_t)g * NTOK + tok0 + tl) * 16 + ch;
                if (dir == 0) {
                    *ypp = acc[r];
                } else {
                    const float y0 = __hip_atomic_load(ypp, __ATOMIC_RELAXED, __HIP_MEMORY_SCOPE_AGENT);
                    const float u = ubuf[tl * 16 + ch];
                    gy[(size_t)(tok0 + tl) * 256 + g * 16 + ch] = f2bf(geluf(y0 + acc[r] + dch * u));
                }
            }
            __builtin_amdgcn_wave_barrier();
            asm volatile("s_waitcnt lgkmcnt(0)" ::: "memory");
        }
        asm volatile("s_waitcnt vmcnt(0)" ::: "memory");
        if (seq < 16 && cis == (dir ? 0 : nch - 1)) {
            float* o = p.out + O_S5 + ((size_t)(((seq * 2 + l) * 2 + dir) * 16 + g) * 64 + lane) * 2;
            o[0] = hr; o[1] = hi;
        }
    }
    __builtin_amdgcn_wave_barrier();
    asm volatile("s_waitcnt lgkmcnt(0)" ::: "memory");
}

constexpr int HS = 68;
DEV void hg_load(const P& p, int l, int gc, int hd, int dir, float* qq, float* kk, float* bq, bool want_q) {
    const float* z = (const float*)(p.ws + WS_Z);
    const int tid = ltid(), d = tid & 63, rq = tid >> 6;
    float lb = 0.f;
    if (l > 0) {
        float e0 = expf(p.hg_lb[(0 * 2 + dir) * 256 + hd * 64 + d]), e1 = expf(p.hg_lb[(1 * 2 + dir) * 256 + hd * 64 + d]);
        lb = e1 / (e0 + e1);
    }
    const int zf = dir ? Z_HGFB : Z_HGFF;
    {
        float zz[16], qv[16];
#pragma unroll
        for (int k = 0; k < 16; ++k) {
            int i = rq + 4 * k;
            int tok = gc * 64 + (dir ? 63 - i : i);
            const float* zr = z + (size_t)tok * ZW;
            zz[k] = zr[zf + hd * 64 + d];
            qv[k] = want_q ? zr[Z_HGQ + hd * 64 + d] : 0.f;
        }
#pragma unroll
        for (int k = 0; k < 16; ++k) {
            int i = rq + 4 * k;
            float sg = sigmf(zz[k]);
            bq[d * HS + i] = __logf(lb + (1.f - lb) * sg);
            kk[d * HS + i] = (1.f - lb) * sigmf(-zz[k]);
            if (want_q) qq[d * HS + i] = qv[k];
        }
    }
    __syncthreads();
    float v[16];
    {
        const float4* src = (const float4*)(bq + d * HS + rq * 16);
        float4 a0 = src[0], a1 = src[1], a2 = src[2], a3 = src[3];
        float t[16] = {a0.x, a0.y, a0.z, a0.w, a1.x, a1.y, a1.z, a1.w, a2.x, a2.y, a2.z, a2.w, a3.x, a3.y, a3.z, a3.w};
        float run = 0.f;
#pragma unroll
        for (int k = 0; k < 16; ++k) { run += t[k]; v[k] = run; }
    }
    bq[d * HS + rq * 16 + 15] = v[15];
    __syncthreads();
    float off = 0.f;
#pragma unroll
    for (int q = 0; q < 3; ++q) off += (q < rq) ? bq[d * HS + q * 16 + 15] : 0.f;
    __syncthreads();
    {
        float4* dst = (float4*)(bq + d * HS + rq * 16);
        dst[0] = make_float4(v[0] + off, v[1] + off, v[2] + off, v[3] + off);
        dst[1] = make_float4(v[4] + off, v[5] + off, v[6] + off, v[7] + off);
        dst[2] = make_float4(v[8] + off, v[9] + off, v[10] + off, v[11] + off);
        dst[3] = make_float4(v[12] + off, v[13] + off, v[14] + off, v[15] + off);
    }
    __syncthreads();
}
DEV void hga_block(const P& p, int l, int item, char* smem) {
    float* kk = (float*)smem;
    float* bq = kk + 64 * HS;
    float* vv = bq + 64 * HS;
    const int dir = item & 1, hd = (item >> 1) & 3, gc = item >> 3;
    const float* z = (const float*)(p.ws + WS_Z);
    const int tid = ltid();
    __syncthreads();
    {
        const int vq = (tid & 15) * 4, i0 = tid >> 4;
#pragma unroll
        for (int k = 0; k < 4; ++k) {
            int i = i0 + 16 * k;
            int tok = gc * 64 + (dir ? 63 - i : i);
            *(float4*)(vv + i * 64 + vq) = *(const float4*)(z + (size_t)tok * ZW + Z_HGI + hd * 64 + vq);
        }
    }
    hg_load(p, l, gc, hd, dir, nullptr, kk, bq, false);
    {
        const int d = tid & 63, rq = tid >> 6;
        const float bl = bq[d * HS + 63];
        float4* kp = (float4*)(kk + d * HS + rq * 16);
        const float4* bp = (const float4*)(bq + d * HS + rq * 16);
#pragma unroll
        for (int k = 0; k < 4; ++k) {
            float4 kv = kp[k], bv = bp[k];
            kv.x *= __expf(bl - bv.x); kv.y *= __expf(bl - bv.y); kv.z *= __expf(bl - bv.z); kv.w *= __expf(bl - bv.w);
            kp[k] = kv;
        }
    }
    __syncthreads();
    float* S = (float*)(p.ws + WS_HGS) + (size_t)item * 4096;
    float* Dd = (float*)(p.ws + WS_HGD) + (size_t)item * 64;
    if (tid < 64) Dd[tid] = __expf(bq[tid * HS + 63]);
    const int db = (tid >> 4) * 4, vb = (tid & 15) * 4;
    float acc[4][4];
#pragma unroll
    for (int a = 0; a < 4; ++a)
#pragma unroll
        for (int b = 0; b < 4; ++b) acc[a][b] = 0.f;
#pragma unroll 2
    for (int i = 0; i < 64; i += 4) {
        float4 kd[4], v4[4];
#pragma unroll
        for (int a = 0; a < 4; ++a) kd[a] = *(const float4*)(kk + (db + a) * HS + i);
#pragma unroll
        for (int ii = 0; ii < 4; ++ii) v4[ii] = *(const float4*)(vv + (i + ii) * 64 + vb);
#pragma unroll
        for (int a = 0; a < 4; ++a) {
            const float ka[4] = {kd[a].x, kd[a].y, kd[a].z, kd[a].w};
#pragma unroll
            for (int ii = 0; ii < 4; ++ii) {
                acc[a][0] += ka[ii] * v4[ii].x; acc[a][1] += ka[ii] * v4[ii].y; acc[a][2] += ka[ii] * v4[ii].z; acc[a][3] += ka[ii] * v4[ii].w;
            }
        }
    }
#pragma unroll
    for (int a = 0; a < 4; ++a) *(float4*)(S + (db + a) * 64 + vb) = make_float4(acc[a][0], acc[a][1], acc[a][2], acc[a][3]);
    __syncthreads();
}
DEV void hgc_block(const P& p, int l, int item) {
    const int chain = item >> 4, sl = item & 15;
    const int dir = chain & 1, hd = (chain >> 1) & 3, seq = chain >> 3;
    const int e = sl * 256 + ltid();
    const int nch = seq < 16 ? 4 : 32, gcb = seq < 16 ? seq * 4 : 64 + (seq - 16) * 32;
    const float* Sb = (const float*)(p.ws + WS_HGS);
    float* Sn = p.out + O_YP;
    const float* Db = (const float*)(p.ws + WS_HGD);
    float S = 0.f;
    if (seq >= 16) S = p.st_hg[(size_t)((((seq - 16) * 2 + l) * 2 + dir) * 4 + hd) * 4096 + e];
    for (int c0 = 0; c0 < nch; c0 += 4) {
        float dS[4], Dv[4];
        size_t its[4];
#pragma unroll
        for (int k = 0; k < 4; ++k) {
            int c = dir ? nch - 1 - (c0 + k) : c0 + k;
            its[k] = (size_t)((gcb + c) * 4 + hd) * 2 + dir;
            dS[k] = Sb[its[k] * 4096 + e];
            Dv[k] = Db[its[k] * 64 + (e >> 6)];
        }
#pragma unroll
        for (int k = 0; k < 4; ++k) {
            Sn[its[k] * 4096 + e] = S;
            S = S * Dv[k] + dS[k];
        }
    }
    if (seq < 16) p.out[O_HG + (size_t)(((seq * 2 + l) * 2 + dir) * 4 + hd) * 4096 + e] = S;
}
DEV void hgb_block(const P& p, int l, int item, char* smem) {
    float* qq = (float*)smem;
    float* kk = qq + 64 * HS;
    float* bq = kk + 64 * HS;
    float* sc = bq + 64 * HS;
    const int hd = item & 3, gc = item >> 2;
    const float* z = (const float*)(p.ws + WS_Z);
    const int tid = ltid();
    __syncthreads();
    const int tb = (tid >> 4) * 4, vb = (tid & 15) * 4;
    float o[4][4];
#pragma unroll
    for (int a = 0; a < 4; ++a)
#pragma unroll
        for (int b = 0; b < 4; ++b) o[a][b] = 0.f;
#pragma nounroll
    for (int dir = 0; dir < 2; ++dir) {
        hg_load(p, l, gc, hd, dir, qq, kk, bq, true);
        const float* Sin = (const float*)(p.out + O_YP) + (size_t)((gc * 4 + hd) * 2 + dir) * 4096;
        const int pvq = (tid & 15) * 4, pr0 = tid >> 4;
#define HG_PF(k_, pvk_, psk_)                                                                     \
        {                                                                                             \
            const int i_ = pr0 + 16 * (k_);                                                           \
            const int tok_ = gc * 64 + (dir ? 63 - i_ : i_);                                          \
            pvk_ = *(const float4*)(z + (size_t)tok_ * ZW + Z_HGI + hd * 64 + pvq);                   \
            psk_ = *(const float4*)(Sin + i_ * 64 + pvq);                                             \
        }
        float4 pv0, pv1, pv2, pv3, ps0, ps1, ps2, ps3;
        HG_PF(0, pv0, ps0) HG_PF(1, pv1, ps1) HG_PF(2, pv2, ps2) HG_PF(3, pv3, ps3)
        {
            const int ib = (tid >> 4) * 4, sbk = (tid & 15) * 4;
            float a[4][4];
#pragma unroll
            for (int x = 0; x < 4; ++x)
#pragma unroll
                for (int y = 0; y < 4; ++y) a[x][y] = 0.f;
            if (sbk < ib) {
#pragma unroll 2
                for (int d = 0; d < 64; ++d) {
                    const float4 qi = *(const float4*)(qq + d * HS + ib), bi = *(const float4*)(bq + d * HS + ib);
                    const float4 ks = *(const float4*)(kk + d * HS + sbk), bs = *(const float4*)(bq + d * HS + sbk);
                    const float br = bi.x;
                    const float qe[4] = {qi.x, qi.y * __expf(bi.y - br), qi.z * __expf(bi.z - br), qi.w * __expf(bi.w - br)};
                    const float kf[4] = {ks.x * __expf(br - bs.x), ks.y * __expf(br - bs.y), ks.z * __expf(br - bs.z), ks.w * __expf(br - bs.w)};
#pragma unroll
                    for (int x = 0; x < 4; ++x)
#pragma unroll
                        for (int y = 0; y < 4; ++y) a[x][y] += qe[x] * kf[y];
                }
            } else if (sbk == ib) {
#pragma unroll 2
                for (int d = 0; d < 64; ++d) {
                    const float4 qi = *(const float4*)(qq + d * HS + ib), bi = *(const float4*)(bq + d * HS + ib);
                    const float4 ks = *(const float4*)(kk + d * HS + sbk);
                    const float qx[4] = {qi.x, qi.y, qi.z, qi.w}, bx[4] = {bi.x, bi.y, bi.z, bi.w}, ky[4] = {ks.x, ks.y, ks.z, ks.w};
#pragma unroll
                    for (int x = 0; x < 4; ++x)
#pragma unroll
                        for (int y = 0; y < 4; ++y)
                            if (y <= x) a[x][y] += qx[x] * ky[y] * __expf(bx[x] - bx[y]);
                }
            }
#pragma unroll
            for (int y = 0; y < 4; ++y) *(float4*)(sc + (sbk + y) * HS + ib) = make_float4(a[0][y], a[1][y], a[2][y], a[3][y]);
        }
        __syncthreads();
        float* vt_ = kk;
        float* st_ = bq;
        *(float4*)(vt_ + (pr0 + 0) * 64 + pvq) = pv0; *(float4*)(vt_ + (pr0 + 16) * 64 + pvq) = pv1;
        *(float4*)(vt_ + (pr0 + 32) * 64 + pvq) = pv2; *(float4*)(vt_ + (pr0 + 48) * 64 + pvq) = pv3;
        {
            const int d = tid & 63, rq = tid >> 6;
            float4* qp = (float4*)(qq + d * HS + rq * 16);
            const float4* bp = (const float4*)(bq + d * HS + rq * 16);
#pragma unroll
            for (int k = 0; k < 4; ++k) {
                float4 qv = qp[k], bv = bp[k];
                qv.x *= __expf(bv.x); qv.y *= __expf(bv.y); qv.z *= __expf(bv.z); qv.w *= __expf(bv.w);
                qp[k] = qv;
            }
        }
        __syncthreads();
        *(float4*)(st_ + (pr0 + 0) * 64 + pvq) = ps0; *(float4*)(st_ + (pr0 + 16) * 64 + pvq) = ps1;
        *(float4*)(st_ + (pr0 + 32) * 64 + pvq) = ps2; *(float4*)(st_ + (pr0 + 48) * 64 + pvq) = ps3;
        __syncthreads();
        const int i0 = dir ? 60 - tb : tb;
#pragma unroll 4
        for (int s = 0; s < 64; ++s) {
            const float4 v4 = *(const float4*)(vt_ + s * 64 + vb);
            const float4 s4 = *(const float4*)(st_ + s * 64 + vb);
            const float4 w4 = *(const float4*)(sc + s * HS + i0);
            const float4 q4 = *(const float4*)(qq + s * HS + i0);
            const float w[4] = {dir ? w4.w : w4.x, dir ? w4.z : w4.y, dir ? w4.y : w4.z, dir ? w4.x : w4.w};
            const float qe[4] = {dir ? q4.w : q4.x, dir ? q4.z : q4.y, dir ? q4.y : q4.z, dir ? q4.x : q4.w};
#pragma unroll
            for (int x = 0; x < 4; ++x) {
                o[x][0] += w[x] * v4.x + qe[x] * s4.x;
                o[x][1] += w[x] * v4.y + qe[x] * s4.y;
                o[x][2] += w[x] * v4.z + qe[x] * s4.z;
                o[x][3] += w[x] * v4.w + qe[x] * s4.w;
            }
        }
        __syncthreads();
    }
    bf16_t* mixed = (bf16_t*)(p.out + 4194304);
    const float4 g4 = *(const float4*)(p.hg_norm + l * 64 + vb);
#pragma unroll
    for (int x = 0; x < 4; ++x) {
        float ss = o[x][0] * o[x][0] + o[x][1] * o[x][1] + o[x][2] * o[x][2] + o[x][3] * o[x][3];
        ss += __shfl_xor(ss, 1); ss += __shfl_xor(ss, 2); ss += __shfl_xor(ss, 4); ss += __shfl_xor(ss, 8);
        float rstd = rsqrtf(ss * (1.f / 64.f) + EPS);
        int tok = gc * 64 + tb + x;
        float4 gt = *(const float4*)(z + (size_t)tok * ZW + Z_HGG + hd * 64 + vb);
        float y0 = o[x][0] * rstd * g4.x * siluf(gt.x), y1 = o[x][1] * rstd * g4.y * siluf(gt.y);
        float y2 = o[x][2] * rstd * g4.z * siluf(gt.z), y3 = o[x][3] * rstd * g4.w * siluf(gt.w);
        *(uint2*)(mixed + (size_t)tok * 1024 + 512 + hd * 64 + vb) = make_uint2(pack2(y0, y1), pack2(y2, y3));
    }
}

constexpr float ATT_THR = 5.0f;
template <int NC, int NDS>
DEV void attn_block(const float* __restrict__ qsrc, int qstride, const bf16_t* __restrict__ kbase, int kstride, const bf16_t* __restrict__ vt,
                    int Lk, const float* __restrict__ tab, bool rope, int t0, float qscale, float lam, float post,
                    const float* __restrict__ norm_g, const float* __restrict__ gate, bf16_t* __restrict__ outp, char* smem,
                    const bf16_t* __restrict__ krope) {
    constexpr int KW = NC * NDS * 16;
    constexpr int KP = KW + 8;
    constexpr int RC = KW / 8;
    constexpr int NKC = (64 * RC) / 256;
    constexpr int KS_STAGE = 64 * KP;
    constexpr int VS_STAGE = 64 * 72;
    bf16_t* Ks = (bf16_t*)smem;
    bf16_t* Vs = Ks + 2 * KS_STAGE;
    const int tid = ltid(), lane = tid & 63, wave = tid >> 6, r = lane & 31, hh = lane >> 5;
    __syncthreads();
    bf16x8 qf[NC][NDS];
    {
        const float* qs = qsrc + (size_t)(wave * 32 + r) * qstride;
#pragma unroll
        for (int c = 0; c < NC; ++c)
#pragma unroll
            for (int ds = 0; ds < NDS; ++ds) {
                const float* s = qs + (c * NDS + ds) * 16 + 8 * hh;
                float4 a = *(const float4*)s, b = *(const float4*)(s + 4);
                float x[8] = {a.x, a.y, a.z, a.w, b.x, b.y, b.z, b.w};
                if (ds >= NDS - 2) {
                    float px[8];
#pragma unroll
                    for (int j = 0; j < 8; ++j) px[j] = __shfl_xor(x[j], 32);
                    if (rope) {
                        int t = t0 + wave * 32 + r;
                        int pos = (ds == NDS - 2) ? (t >> 6) : (t & 63);
#pragma unroll
                        for (int j = 0; j < 8; ++j) {
                            float cs = tab[(pos * 8 + j) * 2], sn = tab[(pos * 8 + j) * 2 + 1];
                            x[j] = hh == 0 ? x[j] * cs - px[j] * sn : px[j] * sn + x[j] * cs;
                        }
                    }
                }
                union { bf16x8 v; uint32_t u[4]; } pk;
#pragma unroll
                for (int j = 0; j < 4; ++j) pk.u[j] = pack2(x[2 * j] * qscale, x[2 * j + 1] * qscale);
                qf[c][ds] = pk.v;
            }
    }
    f32x16 O[NC][2];
    float m[NC], ls[NC];
#pragma unroll
    for (int c = 0; c < NC; ++c) {
        m[c] = -1e30f; ls[c] = 0.f;
#pragma unroll
        for (int e = 0; e < 16; ++e) { O[c][0][e] = 0.f; O[c][1][e] = 0.f; }
    }
    uint4 rk[NKC], rv[2];
    const int vrow = tid >> 3, vcc = tid & 7;
#define ATT_GLOAD(key0_)                                                                                                         \
    {                                                                                                                            \
        _Pragma("unroll") for (int i = 0; i < NKC; ++i) {                                                                        \
            int c = tid + 256 * i;                                                                                               \
            const int cc_ = c % RC, row_ = (key0_) + c / RC;                                                                     \
            rk[i] = (RC <= 8 || cc_ < 8) ? *(const uint4*)(kbase + (size_t)row_ * kstride + cc_ * 8)                            \
                                         : *(const uint4*)(krope + (size_t)row_ * 32 + (cc_ - 8) * 8);                          \
        }                                                                                                                        \
        _Pragma("unroll") for (int i = 0; i < 2; ++i) rv[i] = *(const uint4*)(vt + (size_t)(vrow + 32 * i) * Lk + (key0_) + vcc * 8); \
    }
#define ATT_SWRITE(buf_)                                                                                                         \
    {                                                                                                                            \
        _Pragma("unroll") for (int i = 0; i < NKC; ++i) {                                                                        \
            int c = tid + 256 * i;                                                                                               \
            *(uint4*)(Ks + (buf_) * KS_STAGE + (c / RC) * KP + (c % RC) * 8) = rk[i];                                            \
        }                                                                                                                        \
        _Pragma("unroll") for (int i = 0; i < 2; ++i) *(uint4*)(Vs + (buf_) * VS_STAGE + (vrow + 32 * i) * 72 + vcc * 8) = rv[i]; \
    }
    ATT_GLOAD(0)
    ATT_SWRITE(0)
    __syncthreads();
    const int nt = Lk >> 6;
    for (int kt = 0; kt < nt; ++kt) {
        const int cur = kt & 1;
        if (kt + 1 < nt) ATT_GLOAD((kt + 1) * 64)
        const bf16_t* Kc = Ks + cur * KS_STAGE + r * KP + 8 * hh;
        const bf16_t* Vc = Vs + cur * VS_STAGE + r * 72 + 4 * hh;
#pragma unroll
        for (int sub = 0; sub < 2; ++sub) {
            bf16x8 vf[2][2];
#pragma unroll
            for (int dvb = 0; dvb < 2; ++dvb)
#pragma unroll
                for (int s = 0; s < 2; ++s) {
                    const bf16_t* vp = Vc + dvb * 32 * 72 + sub * 32 + 16 * s;
                    uint2 lo = *(const uint2*)vp, hi = *(const uint2*)(vp + 8);
                    union { bf16x8 v; uint32_t u[4]; } pk;
                    pk.u[0] = lo.x; pk.u[1] = lo.y; pk.u[2] = hi.x; pk.u[3] = hi.y;
                    vf[dvb][s] = pk.v;
                }
#pragma unroll
            for (int c = 0; c < NC; ++c) {
                f32x16 S;
#pragma unroll
                for (int e = 0; e < 16; ++e) S[e] = 0.f;
#pragma unroll
                for (int ds = 0; ds < NDS; ++ds) {
                    bf16x8 kf = *(const bf16x8*)(Kc + sub * 32 * KP + (c * NDS + ds) * 16);
                    S = __builtin_amdgcn_mfma_f32_32x32x16_bf16(kf, qf[c][ds], S, 0, 0, 0);
                }
                float mx = S[0];
#pragma unroll
                for (int e = 1; e < 16; ++e) mx = fmaxf(mx, S[e]);
                {
                    const auto sw = __builtin_amdgcn_permlane32_swap(__float_as_uint(mx), __float_as_uint(mx), false, false);
                    mx = fmaxf(__uint_as_float(sw[0]), __uint_as_float(sw[1]));
                }
                if (__builtin_amdgcn_ballot_w64(mx - m[c] > ATT_THR) != 0ull) {
                    const float mn = fmaxf(m[c], mx);
                    const float alpha = __builtin_amdgcn_exp2f(m[c] - mn);
                    m[c] = mn;
                    ls[c] *= alpha;
#pragma unroll
                    for (int e = 0; e < 16; ++e) { O[c][0][e] *= alpha; O[c][1][e] *= alpha; }
                }
                const float mcur = m[c];
                float rs = 0.f;
#pragma unroll
                for (int e = 0; e < 16; ++e) { S[e] = __builtin_amdgcn_exp2f(S[e] - mcur); rs += S[e]; }
                ls[c] += rs;
#pragma unroll
                for (int s = 0; s < 2; ++s) {
                    union { bf16x8 v; uint32_t u[4]; } pk;
#pragma unroll
                    for (int j = 0; j < 4; ++j) pk.u[j] = pack2(S[8 * s + 2 * j], S[8 * s + 2 * j + 1]);
                    O[c][0] = __builtin_amdgcn_mfma_f32_32x32x16_bf16(vf[0][s], pk.v, O[c][0], 0, 0, 0);
                    O[c][1] = __builtin_amdgcn_mfma_f32_32x32x16_bf16(vf[1][s], pk.v, O[c][1], 0, 0, 0);
                }
            }
        }
        if (kt + 1 < nt) ATT_SWRITE(cur ^ 1)
        __syncthreads();
    }
    float inv[NC];
#pragma unroll
    for (int c = 0; c < NC; ++c) { float lt = ls[c] + __shfl_xor(ls[c], 32); inv[c] = 1.f / lt; }
    float o[2][16];
    float ss = 0.f;
#pragma unroll
    for (int dvb = 0; dvb < 2; ++dvb)
#pragma unroll
        for (int e = 0; e < 16; ++e) {
            float v = O[0][dvb][e] * inv[0];
            if constexpr (NC == 2) v -= lam * O[1][dvb][e] * inv[1];
            o[dvb][e] = v;
            ss += v * v;
        }
    float rstd = 1.f;
    if constexpr (NC == 2) {
        ss += __shfl_xor(ss, 32);
        rstd = rsqrtf(ss * (1.f / 64.f) + EPS) * post;
    }
    const int qrow = wave * 32 + r;
#pragma unroll
    for (int dvb = 0; dvb < 2; ++dvb)
#pragma unroll
        for (int g4 = 0; g4 < 4; ++g4) {
            int dv = dvb * 32 + 8 * g4 + 4 * hh;
            float4 gt = *(const float4*)(gate + (size_t)qrow * ZW + dv);
            float y0 = o[dvb][4 * g4 + 0] * rstd * siluf(gt.x), y1 = o[dvb][4 * g4 + 1] * rstd * siluf(gt.y);
            float y2 = o[dvb][4 * g4 + 2] * rstd * siluf(gt.z), y3 = o[dvb][4 * g4 + 3] * rstd * siluf(gt.w);
            if constexpr (NC == 2) {
                float4 ng = *(const float4*)(norm_g + dv);
                y0 *= ng.x; y1 *= ng.y; y2 *= ng.z; y3 *= ng.w;
            }
            *(uint2*)(outp + (size_t)qrow * 1024 + dv) = make_uint2(pack2(y0, y1), pack2(y2, y3));
        }
}

DEV void attn_item(const P& p, int l, int kind, int seq, int hd, int qb, char* smem) {
    const float* z = (const float*)(p.ws + WS_Z);
    const float* tab = (const float*)(p.ws + WS_ROPE);
    const float* lamp = (const float*)(p.ws + WS_LAM);
    bf16_t* mixed = (bf16_t*)(p.out + 4194304);
    const int tq0 = seq_tok0(seq) + qb * 128, kr0 = seq_kr0(seq), lk = seq_lk(seq);
    const bool rope = seq >= 16;
    const float LOG2E = 1.4426950408889634f;
    if (kind == 0) {
        attn_block<2, 2>(z + (size_t)tq0 * ZW + Z_DAQ + hd * 64, ZW, (const bf16_t*)(p.ws + WS_KD) + (size_t)kr0 * 256 + hd * 64, 256,
                         (const bf16_t*)(p.ws + WS_VDT) + seq_vt0(seq) + (size_t)hd * 64 * lk, lk, tab, rope, qb * 128,
                         0.17677669529663687f * LOG2E, lamp[l], 1.f - lamp[2 + l], p.da_norm + l * 64,
                         z + (size_t)tq0 * ZW + Z_DAG + hd * 64, mixed + (size_t)tq0 * 1024 + hd * 64, smem, nullptr);
    } else {
        attn_block<1, 6>((const float*)(p.ws + WS_QRAW) + (size_t)tq0 * 384 + hd * 96, 384, (const bf16_t*)(p.ws + WS_KMLA) + (size_t)kr0 * 384 + hd * 96, 384,
                         (const bf16_t*)(p.ws + WS_VMT) + seq_vt0(seq) + (size_t)hd * 64 * lk, lk, tab, rope, qb * 128,
                         0.10206207261596575f * LOG2E, 0.f, 1.f, nullptr,
                         z + (size_t)tq0 * ZW + Z_MLAG + hd * 64, mixed + (size_t)tq0 * 1024 + 768 + hd * 64, smem,
                         (const bf16_t*)(p.ws + WS_KROPE) + (size_t)kr0 * 32);
    }
}

#define XB_TMO      128
#define XB_XCNT(j)  (256  + 64 * (j))
#define XB_XSUB(j)  (1280 + 64 * (j))
#define XB_XGEN(j)  (2304 + 64 * (j))
#define XB_TOP      3328
#define XB_TOPGEN   3392
#define XCD_BAR_WORDS 3456
#define XB_SPIN_CAP (1u << 20)
#define LAS __attribute__((address_space(3)))
DEV unsigned xb_ld(unsigned* p) { return __hip_atomic_load(p, __ATOMIC_RELAXED, __HIP_MEMORY_SCOPE_AGENT); }
DEV unsigned xb_add(unsigned* p, unsigned v) { return __hip_atomic_fetch_add(p, v, __ATOMIC_RELAXED, __HIP_MEMORY_SCOPE_AGENT); }
DEV unsigned xb_xcc_id() { return (unsigned)__builtin_amdgcn_s_getreg((3 << 11) | 20) & 0xFu; }
#define XB_SPIN(cond, bar) do { unsigned _sp = 0; while (cond) { __builtin_amdgcn_s_sleep(1); \
    if ((++_sp & 255u) == 0u) { if (xb_ld(&(bar)[XB_TMO])) break; if (_sp > XB_SPIN_CAP) { atomicAdd(&(bar)[XB_TMO], 1u); break; } } } } while (0)
struct XcdBarrier { unsigned* bar; unsigned x; volatile LAS unsigned* st; };
DEV XcdBarrier xcd_barrier_post(unsigned* bar, volatile LAS unsigned* st) {
    XcdBarrier b; b.bar = bar; b.x = xb_xcc_id(); b.st = st;
    if (threadIdx.x == 0) (void)xb_add(&bar[XB_XCNT(b.x)], 1u);
    return b;
}
DEV void xcd_barrier_complete(unsigned* bar, unsigned x, unsigned& nloc, unsigned& nx) {
    const unsigned G = gridDim.x * gridDim.y * gridDim.z;
    unsigned sum, cnt, mine, sp = 0u;
    for (;;) {
        sum = 0u; cnt = 0u; mine = 0u;
#pragma unroll
        for (unsigned j = 0; j < 16; ++j) { const unsigned c = xb_ld(&bar[XB_XCNT(j)]); sum += c; cnt += (c > 0u) ? 1u : 0u; mine = (j == x) ? c : mine; }
        if (sum == G) break;
        __builtin_amdgcn_s_sleep(1);
        if ((++sp & 255u) == 0u) { if (xb_ld(&bar[XB_TMO])) break; if (sp > XB_SPIN_CAP) { atomicAdd(&bar[XB_TMO], 1u); break; } }
    }
    nloc = mine > 0u ? mine : 1u; nx = cnt > 0u ? cnt : 1u;
}
DEV void xcd_barrier(const XcdBarrier& b) {
    asm volatile("s_waitcnt vmcnt(0)" ::: "memory");
    __syncthreads();
    if (threadIdx.x == 0) {
        unsigned* bar = b.bar;
        __builtin_amdgcn_s_waitcnt(0);
        unsigned nloc = b.st[0], nx = b.st[1];
        if (nloc == 0u) { xcd_barrier_complete(bar, b.x, nloc, nx); b.st[0] = nloc; b.st[1] = nx; }
        const unsigned old = xb_add(&bar[XB_XSUB(b.x)], 1u);
        const unsigned gen = old / nloc;
        if (old + 1u == (gen + 1u) * nloc) {
            __builtin_amdgcn_fence(__ATOMIC_RELEASE, "agent");
            asm volatile("s_waitcnt vmcnt(0)" ::: "memory");
            const unsigned og = xb_add(&bar[XB_TOP], 1u);
            const unsigned tg = og / nx;
            if (og + 1u == (tg + 1u) * nx) xb_add(&bar[XB_TOPGEN], 1u);
            else XB_SPIN(xb_ld(&bar[XB_TOPGEN]) == tg, bar);
            __builtin_amdgcn_fence(__ATOMIC_ACQUIRE, "agent");
            xb_add(&bar[XB_XGEN(b.x)], 1u);
            asm volatile("s_waitcnt vmcnt(0)" ::: "memory");
        } else {
            XB_SPIN(xb_ld(&bar[XB_XGEN(b.x)]) == gen, bar);
            __builtin_amdgcn_fence(__ATOMIC_ACQUIRE, "agent");
            asm volatile("s_waitcnt vmcnt(0)" ::: "memory");
        }
    }
    __syncthreads();
}

DEV int sub_start(int bid, int off, int G) { int r = (bid - off) % G; return r < 0 ? r + G : r; }
__global__ void __launch_bounds__(256, 2) fwd_megakernel(P p) {
    extern __shared__ __attribute__((aligned(16))) char smem[];
    cg::grid_group grid = cg::this_grid();
    const int G = gridDim.x, bid = blockIdx.x;
    if (p.out == nullptr) grid.sync();
    volatile LAS unsigned* xst = (volatile LAS unsigned*)(smem + SMEM_WORK);
    if (threadIdx.x == 0) { xst[0] = 0u; xst[1] = 0u; xst[2] = 0u; xst[3] = 0u; }
    __syncthreads();
    const XcdBarrier xb = xcd_barrier_post((unsigned*)(p.ws + WS_BAR), xst);

    phase0(p, smem, 0);
    xcd_barrier(xb);
    phase0(p, smem, 1);
    for (int j = bid; j < ZW / 64; j += G) bias_block(p, j, smem);
    for (int e = bid * 256 + ltid(); e < 2 * 3 * 3072; e += G * 256) {
        const int j = e % 3072, lc = e / 3072;
        ((float*)(p.ws + WS_MODS))[e] = mod_val((const float*)(p.ws + WS_MODP), lc / 3, lc % 3, j);
    }
    phase_rownorm(p, 0, 0);
    xcd_barrier(xb);
    for (int rep = 0; rep < REP_SYNC; ++rep) xcd_barrier(xb);
#pragma nounroll
    for (int l = 0; l < 2; ++l) {
        for (int rep = 0; rep < REP_P1; ++rep) {
        {
            const bf16_t* A = (const bf16_t*)(p.ws + WS_H);
            const bf16_t* Bt = (const bf16_t*)(p.ws + WS_WIN) + (size_t)l * ZW * 1024;
            for (int t = bid; t < 64 * 27; t += G) gemm_tile<EPI_INPROJ>(p, l, A, 1024, Bt, 1024, 1024, (t & 63) * 128, (t >> 6) * 128, smem);
        }
        xcd_barrier(xb);
        }
        for (int rep = 0; rep < REP_X1; ++rep) {
        {
            constexpr int N_PREP = 408, N_HGA = 1024, N_S5A = 1024;
            for (int rr = 0; rr < REP_PREP; ++rr)
            for (int j = sub_start(bid, 0, G); j < N_PREP; j += G) prep_chunk(p, l, j, smem);
            for (int rr = 0; rr < REP_HGA; ++rr)
            for (int j = sub_start(bid, N_PREP, G); j < N_HGA; j += G) hga_block(p, l, j, smem);
            __syncthreads();
            for (int rr = 0; rr < REP_S5A; ++rr)
            for (int j = sub_start(bid, N_PREP + N_HGA, G); j < N_S5A; j += G) { const int wave = ltid() >> 6; s5a_wave(p, l, j * 4 + wave, smem + wave * 4096); }
        }
        xcd_barrier(xb);
        }
        for (int rep = 0; rep < REP_X2; ++rep) {
        {
            const bf16_t* cqn = (const bf16_t*)(p.ws + WS_CQN);
            const bf16_t* ckvn = (const bf16_t*)(p.ws + WS_CKVN);
            const bf16_t* WuqT = (const bf16_t*)(p.ws + WS_WUQ) + (size_t)l * 384 * 192;
            const bf16_t* WukvT = (const bf16_t*)(p.ws + WS_WUKV) + (size_t)l * 512 * 128;
            constexpr int N_UQ = 64 * 3, N_UKV = 68 * 4, N_HGC = 144 * 16;
            for (int j = sub_start(bid, 0, G); j < N_UQ; j += G) gemm_tile<EPI_UQ>(p, l, cqn, 192, WuqT, 192, 192, (j / 3) * 128, (j % 3) * 128, smem);
            for (int j = sub_start(bid, N_UQ, G); j < N_UKV; j += G) gemm_tile<EPI_UKV>(p, l, ckvn, 128, WukvT, 128, 128, (j >> 2) * 128, (j & 3) * 128, smem);
            for (int j = sub_start(bid, N_UQ + N_UKV, G); j < N_HGC; j += G) hgc_block(p, l, j);
        }
        xcd_barrier(xb);
        }
        for (int rep = 0; rep < REP_X3; ++rep) {
        {
            constexpr int N_AH = 256, N_HGB = 512, N_S5B = 512, N_AL = 256;
            for (int rr = 0; rr < REP_AH; ++rr)
            for (int j = sub_start(bid, 0, G); j < N_AH; j += G) {
                int kind = j & 1, hd = (j >> 1) & 3, sq = (j >> 3) & 1, qb = j >> 4;
                attn_item(p, l, kind, 16 + sq, hd, qb, smem);
            }
            for (int rr = 0; rr < REP_HGB; ++rr)
            for (int j = sub_start(bid, N_AH, G); j < N_HGB; j += G) hgb_block(p, l, j, smem);
            __syncthreads();
            if (G == 512) {
                const int b = bid & 255, e = b >> 1;
                const bool up = bid >= 256;
                int it0 = -1, it1 = -1;
                if ((b & 1) == 0) { if (up) it0 = 4 * e; }
                else if (!up) it0 = 4 * e + 1;
                else { it0 = 4 * e + 2; it1 = 4 * e + 3; }
                const int wave = ltid() >> 6;
                if (it0 >= 0) s5b_wave(p, l, it0 * 4 + wave, smem + wave * S5B_LDS);
                if (it1 >= 0) s5b_wave(p, l, it1 * 4 + wave, smem + wave * S5B_LDS);
            } else {
                for (int j = sub_start(bid, N_AH + N_HGB, G); j < N_S5B; j += G) { const int wave = ltid() >> 6; s5b_wave(p, l, j * 4 + wave, smem + wave * S5B_LDS); }
            }
            for (int j = sub_start(bid, N_AH + N_HGB + N_S5B, G); j < N_AL; j += G) {
                int kind = j & 1, hd = (j >> 1) & 3, qb = (j >> 3) & 1, sq = j >> 4;
                attn_item(p, l, kind, sq, hd, qb, smem);
            }
        }
        xcd_barrier(xb);
        }
        for (int rep = 0; rep < REP_X4; ++rep) {
        {
            const bf16_t* gy = (const bf16_t*)(p.ws + WS_GY);
            const bf16_t* WgluT = (const bf16_t*)(p.ws + WS_WGLU) + (size_t)l * 512 * 256;
            for (int t = bid; t < 64 * 4; t += G) gemm_tile<EPI_GLU>(p, l, gy, 256, WgluT, 256, 256, (t & 63) * 128, (t >> 6) * 128, smem);
        }
        xcd_barrier(xb);
        }
        for (int rep = 0; rep < REP_P3; ++rep) {
        {
            const bf16_t* A = (const bf16_t*)(p.out + 4194304);
            const bf16_t* Bt = (const bf16_t*)(p.ws + WS_WOUT) + (size_t)l * 1024 * 1024;
            for (int t = bid; t < 64 * 8; t += G) gemm_tile<EPI_OUT>(p, l, A, 1024, Bt, 1024, 1024, (t & 63) * 128, (t >> 6) * 128, smem);
        }
        xcd_barrier(xb);
        }
    }
    phase_rownorm(p, 1, 1);
}

extern "C" void kernel_launch(void* const* d_in, const int* in_sizes, int n_in, void* d_out, int out_size, void* d_ws, size_t ws_size,
                              hipStream_t stream) {
    static int grid_blocks = 0;
    if (grid_blocks == 0) {
        int dev = 0, cus = 0, per_cu = 0;
        hipGetDevice(&dev);
        hipDeviceGetAttribute(&cus, hipDeviceAttributeMultiprocessorCount, dev);
        hipFuncSetAttribute((const void*)fwd_megakernel, hipFuncAttributeMaxDynamicSharedMemorySize, SMEM_BYTES);
        hipOccupancyMaxActiveBlocksPerMultiprocessor(&per_cu, (const void*)fwd_megakernel, 256, SMEM_BYTES);
        if (per_cu < 1) per_cu = 1;
        if (per_cu > 2) per_cu = 2;
        grid_blocks = cus * per_cu;
        if (ws_size < WS_END || n_in != 32) { fprintf(stderr, "kernel_launch: unexpected ws_size %zu / n_in %d\n", ws_size, n_in); }
    }
    if (hipMemsetAsync((char*)d_ws + WS_BAR, 0, 16384, stream) != hipSuccess) fprintf(stderr, "memset of barrier words failed\n");
    P p{};
    const float** f = (const float**)&p;
    for (int i = 0; i < 32; ++i) f[i] = (const float*)d_in[i];
    p.out = (float*)d_out;
    p.ws = (char*)d_ws;
    void* args[] = {&p};
    hipError_t e = hipLaunchCooperativeKernel((const void*)fwd_megakernel, dim3(grid_blocks), dim3(256), args, SMEM_BYTES, stream);
    if (e != hipSuccess) fprintf(stderr, "cooperative launch failed: %s (grid %d)\n", hipGetErrorString(e), grid_blocks);
}
```

```cpp
#include <hip/hip_runtime.h>
#include <hip/hip_cooperative_groups.h>
#include <stdint.h>
#include <stdio.h>
namespace cg = cooperative_groups;

typedef unsigned short bf16_t;
using bf16x8 = __attribute__((ext_vector_type(8))) short;
using f32x4 = __attribute__((ext_vector_type(4))) float;
using f32x16 = __attribute__((ext_vector_type(16))) float;
#define DEV __device__ __forceinline__

constexpr int NTOK = 8192, NCTX = 4096, ZW = 3456, INW = 3424, KROWS = 8704;
constexpr int Z_DAQ = 0, Z_DAK = 256, Z_DAV = 512, Z_DAG = 768, Z_S5U = 1024, Z_S5G = 1280, Z_HGQ = 1536, Z_HGFF = 1792,
              Z_HGFB = 2048, Z_HGI = 2304, Z_HGG = 2560, Z_CQ = 2816, Z_CKV = 3008, Z_KR = 3136, Z_MLAG = 3168;
constexpr size_t O_YP = 0, O_DK = 8388608, O_DV = 10485760, O_S5 = 12582912, O_HG = 12713984, O_CKV = 13762560, O_KR = 14811136;
constexpr float EPS = 1e-6f;

constexpr size_t al256(size_t x) { return (x + 255) & ~(size_t)255; }
constexpr size_t WS_WIN = 0;
constexpr size_t WS_WOUT = WS_WIN + (size_t)2 * ZW * 1024 * 2;
constexpr size_t WS_WGLU = WS_WOUT + (size_t)2 * 1024 * 1024 * 2;
constexpr size_t WS_WUQ = WS_WGLU + (size_t)2 * 512 * 256 * 2;
constexpr size_t WS_WUKV = WS_WUQ + (size_t)2 * 384 * 192 * 2;
constexpr size_t WS_MODP = WS_WUKV + (size_t)2 * 512 * 128 * 2;
constexpr size_t WS_ROPE = WS_MODP + (size_t)4 * 2 * 3 * 3072 * 4;
constexpr size_t WS_LAM = WS_ROPE + 4096;
constexpr size_t WS_H = WS_LAM + 256;
constexpr size_t WS_Z = WS_H + (size_t)NTOK * 1024 * 2;
constexpr size_t WS_KD = WS_Z + (size_t)NTOK * ZW * 4;
constexpr size_t WS_VDT = WS_KD + (size_t)KROWS * 256 * 2;
constexpr size_t VT_ELEMS = (size_t)16 * 4 * 64 * 256 + (size_t)2 * 4 * 64 * 2304;
constexpr size_t WS_KMLA = WS_VDT + VT_ELEMS * 2;
constexpr size_t WS_VMT = WS_KMLA + (size_t)KROWS * 384 * 2;
constexpr size_t WS_CQN = WS_VMT + VT_ELEMS * 2;
constexpr size_t WS_CKVN = WS_CQN + (size_t)NTOK * 192 * 2;
constexpr size_t WS_QRAW = WS_CKVN + (size_t)KROWS * 128 * 2;
constexpr size_t WS_S5F = WS_QRAW + (size_t)NTOK * 384 * 4;
constexpr size_t WS_HGS = WS_S5F + (size_t)128 * 2 * 16 * 64 * 2 * 4;
constexpr size_t WS_HGD = WS_HGS + (size_t)1024 * 4096 * 4;
constexpr size_t WS_GY = WS_HGD + (size_t)1024 * 64 * 4;
constexpr size_t WS_X1 = WS_GY + (size_t)NTOK * 256 * 2;
constexpr size_t WS_END = WS_X1 + (size_t)NTOK * 1024 * 4;
constexpr size_t WS_BAR = WS_END;
constexpr size_t WS_YP = WS_BAR + 16384;
constexpr size_t WS_KROPE = WS_YP + (size_t)NTOK * 256 * 4;
constexpr size_t WS_BIAS = WS_KROPE + (size_t)KROWS * 32 * 2;
constexpr size_t WS_SSQ = WS_BIAS + (size_t)3 * ZW * 4;
constexpr size_t WS_MODS = WS_SSQ + (size_t)16 * NTOK * 4;
constexpr size_t WS_TOTAL = WS_MODS + (size_t)2 * 3 * 3072 * 4;
static_assert(WS_TOTAL <= (size_t)256 * 1024 * 1024, "workspace too large");

#ifndef REP_AH
#define REP_AH 1
#endif
#ifndef REP_HGB
#define REP_HGB 1
#endif
#ifndef REP_S5B
#define REP_S5B 1
#endif
#ifndef REP_AL
#define REP_AL 1
#endif
#ifndef REP_PREP
#define REP_PREP 1
#endif
#ifndef REP_HGA
#define REP_HGA 1
#endif
#ifndef REP_S5A
#define REP_S5A 1
#endif
#ifndef REP_X2
#define REP_X2 1
#endif
#ifndef REP_P0
#define REP_P0 1
#endif
#ifndef REP_P1
#define REP_P1 1
#endif
#ifndef REP_X1
#define REP_X1 1
#endif
#ifndef REP_X3
#define REP_X3 1
#endif
#ifndef REP_X4
#define REP_X4 1
#endif
#ifndef REP_P3
#define REP_P3 1
#endif
#ifndef REP_SYNC
#define REP_SYNC 0
#endif
constexpr int SMEM_WORK = 2 * 2 * 128 * 72 * 2;
constexpr int SMEM_BYTES = SMEM_WORK + 16;

struct P {
    const float *x_prompt, *x_sample, *cdk, *cdv, *st_s5, *st_hg, *cckv, *ckrope, *c, *c_ctx, *w_mod, *b_mod, *w_in, *w_out,
        *da_lambda, *da_norm, *s5_a_re, *s5_a_im, *s5_log_dt, *s5_b_re, *s5_b_im, *s5_c_re, *s5_c_im, *s5_d, *s5_w_glu, *hg_lb,
        *hg_norm, *mla_q_norm, *mla_w_uq, *mla_kv_norm, *mla_w_ukv, *final_norm;
    float* out;
    char* ws;
};

DEV int ltid() { int t = threadIdx.x; asm volatile("" : "+v"(t)); return t; }
typedef __bf16 bf2_t __attribute__((ext_vector_type(2)));
typedef float f2_t __attribute__((ext_vector_type(2)));
DEV uint32_t pack2(float a, float b) {
    f2_t v = {a, b};
    bf2_t r = __builtin_convertvector(v, bf2_t);
    uint32_t u;
    __builtin_memcpy(&u, &r, 4);
    return u;
}
DEV bf16_t f2bf(float f) { return (bf16_t)(pack2(f, 0.f) & 0xffffu); }
DEV float siluf(float x) { return x / (1.f + __expf(-x)); }
DEV float sigmf(float x) { return 1.f / (1.f + __expf(-x)); }
DEV float geluf(float x) {
    float a = 0.7978845608028654f * (x + 0.044715f * x * x * x);
    float t = 1.f - 2.f / (__expf(2.f * a) + 1.f);
    return 0.5f * x * (1.f + t);
}
DEV float wave_sum(float v) {
#pragma unroll
    for (int o = 32; o >= 1; o >>= 1) v += __shfl_xor(v, o);
    return v;
}
DEV int tok_seq(int tok) { return tok < NCTX ? (tok >> 8) : 16 + ((tok - NCTX) >> 11); }
DEV int tok_cond(int tok) { return tok < NCTX ? 0 : 1 + ((tok - NCTX) >> 11); }
DEV int seq_tok0(int seq) { return seq < 16 ? seq * 256 : NCTX + (seq - 16) * 2048; }
DEV int seq_kr0(int seq) { return seq < 16 ? seq * 256 : NCTX + (seq - 16) * 2304; }
DEV int seq_lk(int seq) { return seq < 16 ? 256 : 2304; }
DEV size_t seq_vt0(int seq) { return seq < 16 ? (size_t)seq * 65536 : (size_t)1048576 + (size_t)(seq - 16) * 589824; }
DEV float mod_val(const float* modp, int l, int cond, int j) {
    float s = 0.f;
#pragma unroll
    for (int q = 0; q < 4; ++q) s += modp[((q * 2 + l) * 3 + cond) * 3072 + j];
    return s;
}

DEV void transpose_tile(const float* __restrict__ src, int K, int Nsrc, bf16_t* __restrict__ dst, int k0, int n0, int mode, float* tile) {
    int tid = ltid(), tx = tid & 63, ty = tid >> 6;
    int n = n0 + tx;
    int sc = (mode == 0) ? (n < Nsrc ? n : -1) : (((n >> 4) & 1) * 256 + (n >> 5) * 16 + (n & 15));
#pragma unroll 4
    for (int i = 0; i < 16; ++i) {
        int k = ty + 4 * i;
        tile[k * 65 + tx] = sc >= 0 ? src[(size_t)(k0 + k) * Nsrc + sc] : 0.f;
    }
    __syncthreads();
    int nl = tid >> 2, kq = tid & 3;
    uint32_t w[8];
#pragma unroll
    for (int j = 0; j < 8; ++j) w[j] = pack2(tile[(kq * 16 + 2 * j) * 65 + nl], tile[(kq * 16 + 2 * j + 1) * 65 + nl]);
    uint4* d = (uint4*)(dst + (size_t)(n0 + nl) * K + k0 + kq * 16);
    d[0] = make_uint4(w[0], w[1], w[2], w[3]);
    d[1] = make_uint4(w[4], w[5], w[6], w[7]);
    __syncthreads();
}

DEV void phase0(const P& p, char* smem, int part) {
    float* tile = (float*)smem;
    bf16_t* WinT = (bf16_t*)(p.ws + WS_WIN);
    bf16_t* WoutT = (bf16_t*)(p.ws + WS_WOUT);
    bf16_t* WgluT = (bf16_t*)(p.ws + WS_WGLU);
    bf16_t* WuqT = (bf16_t*)(p.ws + WS_WUQ);
    bf16_t* WukvT = (bf16_t*)(p.ws + WS_WUKV);
    float* modp = (float*)(p.ws + WS_MODP);
    constexpr int T_IN = 16 * 54, T_OUT = 16 * 16, T_GLU = 4 * 8, T_UQ = 3 * 6, T_UKV = 2 * 8;
    constexpr int T_L = T_IN + T_OUT + T_GLU + T_UQ + T_UKV;
    constexpr int N_MOD = 2 * 48 * 4;
    constexpr int TOTAL = N_MOD + 1 + 2 * T_L;
    const int it_lo = part == 0 ? 0 : N_MOD + 1, it_hi = part == 0 ? N_MOD + 1 : TOTAL;
    for (int it = it_lo + blockIdx.x; it < it_hi; it += gridDim.x) {
        if (it < N_MOD) {
            int l = it / 192, rem = it % 192, cb = rem >> 2, kq = rem & 3;
            int tid = ltid(), cl = tid & 63, kg = tid >> 6, col = cb * 64 + cl, kb = kq * 256 + kg * 64;
            float a0 = 0.f, a1 = 0.f, a2 = 0.f;
            const float* w = p.w_mod + ((size_t)l * 1024 + kb) * 3072 + col;
#pragma unroll 4
            for (int k = 0; k < 64; ++k) {
                float wv = w[(size_t)k * 3072];
                a0 += siluf(p.c_ctx[kb + k]) * wv;
                a1 += siluf(p.c[kb + k]) * wv;
                a2 += siluf(p.c[1024 + kb + k]) * wv;
            }
            tile[(0 * 4 + kg) * 64 + cl] = a0;
            tile[(1 * 4 + kg) * 64 + cl] = a1;
            tile[(2 * 4 + kg) * 64 + cl] = a2;
            __syncthreads();
            if (tid < 192) {
                int cond = tid >> 6;
                float s = tile[(cond * 4 + 0) * 64 + cl] + tile[(cond * 4 + 1) * 64 + cl] + tile[(cond * 4 + 2) * 64 + cl] + tile[(cond * 4 + 3) * 64 + cl];
                if (kq == 0) s += p.b_mod[l * 3072 + col];
                modp[((kq * 2 + l) * 3 + cond) * 3072 + col] = s;
            }
            __syncthreads();
        } else if (it == N_MOD) {
            float* tab = (float*)(p.ws + WS_ROPE);
            float* lam = (float*)(p.ws + WS_LAM);
            for (int e = ltid(); e < 512; e += 256) {
                int pos = e >> 3, f = e & 7;
                float inv = powf(10000.f, -(float)f / 8.f);
                float ang = (float)pos * inv;
                tab[e * 2] = cosf(ang);
                tab[e * 2 + 1] = sinf(ang);
            }
            if (ltid() < 2) {
                int l = ltid();
                const float* lv = p.da_lambda + l * 128;
                float s1 = 0.f, s2 = 0.f;
                for (int i = 0; i < 32; ++i) { s1 += lv[i] * lv[32 + i]; s2 += lv[64 + i] * lv[96 + i]; }
                float li = 0.8f - 0.6f * expf(-0.3f * (float)l);
                lam[l] = expf(s1) - expf(s2) + li;
                lam[2 + l] = li;
            }
        } else {
            int j = it - N_MOD - 1, l = j / T_L, r = j % T_L;
            if (r < T_IN) {
                transpose_tile(p.w_in + (size_t)l * 1024 * INW, 1024, INW, WinT + (size_t)l * ZW * 1024, (r / 54) * 64, (r % 54) * 64, 0, tile);
            } else if ((r -= T_IN) < T_OUT) {
                transpose_tile(p.w_out + (size_t)l * 1024 * 1024, 1024, 1024, WoutT + (size_t)l * 1024 * 1024, (r / 16) * 64, (r % 16) * 64, 0, tile);
            } else if ((r -= T_OUT) < T_GLU) {
                transpose_tile(p.s5_w_glu + (size_t)l * 256 * 512, 256, 512, WgluT + (size_t)l * 512 * 256, (r / 8) * 64, (r % 8) * 64, 1, tile);
            } else if ((r -= T_GLU) < T_UQ) {
                transpose_tile(p.mla_w_uq + (size_t)l * 192 * 384, 192, 384, WuqT + (size_t)l * 384 * 192, (r / 6) * 64, (r % 6) * 64, 0, tile);
            } else {
                r -= T_UQ;
                transpose_tile(p.mla_w_ukv + (size_t)l * 128 * 512, 128, 512, WukvT + (size_t)l * 512 * 128, (r / 8) * 64, (r % 8) * 64, 0, tile);
            }
        }
    }
}

DEV void bias_block(const P& p, int item, char* smem) {
    float* sh = (float*)smem;
    float* red = sh + 3 * 1024;
    const float* modp = (const float*)(p.ws + WS_MODP);
    const int tid = ltid(), cl = tid & 63, kg = tid >> 6, col = item * 64 + cl;
    __syncthreads();
    for (int idx = tid; idx < 3072; idx += 256) sh[idx] = mod_val(modp, 1, idx >> 10, idx & 1023);
    __syncthreads();
    float a0 = 0.f, a1 = 0.f, a2 = 0.f;
    if (col < INW) {
        const float* w = p.w_in + ((size_t)1024 + kg * 256) * INW + col;
#pragma unroll 8
        for (int k = 0; k < 256; ++k) {
            const float wv = w[(size_t)k * INW];
            a0 += sh[kg * 256 + k] * wv; a1 += sh[1024 + kg * 256 + k] * wv; a2 += sh[2048 + kg * 256 + k] * wv;
        }
    }
    red[(0 * 4 + kg) * 64 + cl] = a0; red[(1 * 4 + kg) * 64 + cl] = a1; red[(2 * 4 + kg) * 64 + cl] = a2;
    __syncthreads();
    if (tid < 192) {
        const int c = tid >> 6;
        ((float*)(p.ws + WS_BIAS))[c * ZW + item * 64 + cl] =
            red[(c * 4 + 0) * 64 + cl] + red[(c * 4 + 1) * 64 + cl] + red[(c * 4 + 2) * 64 + cl] + red[(c * 4 + 3) * 64 + cl];
    }
    __syncthreads();
}

DEV void phase_rownorm(const P& p, int l, int final_mode) {
    const float* modp = (const float*)(p.ws + WS_MODP);
    bf16_t* h = (bf16_t*)(p.ws + WS_H);
    int lane = ltid() & 63, wave = ltid() >> 6;
    for (int row = blockIdx.x * 4 + wave; row < NTOK; row += gridDim.x * 4) {
        const float* src;
        if (final_mode) src = row < NCTX ? (const float*)(p.ws + WS_H) + (size_t)row * 1024 : (const float*)(p.ws + WS_HGS) + (size_t)(row - NCTX) * 1024;
        else if (l == 0) src = row < NCTX ? p.x_prompt + (size_t)row * 1024 : p.x_sample + (size_t)(row - NCTX) * 1024;
        else src = (const float*)(p.ws + WS_X1) + (size_t)row * 1024;
        float4 v[4];
        float ss = 0.f;
#pragma unroll
        for (int i = 0; i < 4; ++i) {
            v[i] = ((const float4*)src)[lane + 64 * i];
            ss += v[i].x * v[i].x + v[i].y * v[i].y + v[i].z * v[i].z + v[i].w * v[i].w;
        }
        ss = wave_sum(ss);
        float rstd = rsqrtf(ss * (1.f / 1024.f) + EPS);
        if (final_mode) {
#pragma unroll
            for (int i = 0; i < 4; ++i) {
                int j = (lane + 64 * i) * 4;
                float4 g = *(const float4*)(p.final_norm + j);
                float4 o = make_float4(v[i].x * rstd * g.x, v[i].y * rstd * g.y, v[i].z * rstd * g.z, v[i].w * rstd * g.w);
                *(float4*)(p.out + O_YP + (size_t)row * 1024 + j) = o;
            }
        } else {
            int cond = tok_cond(row);
#pragma unroll
            for (int i = 0; i < 4; ++i) {
                int j = (lane + 64 * i) * 4;
                float sh[4], sc[4];
#pragma unroll
                for (int e = 0; e < 4; ++e) { sh[e] = mod_val(modp, l, cond, j + e); sc[e] = mod_val(modp, l, cond, 1024 + j + e); }
                float o0 = v[i].x * rstd * (1.f + sc[0]) + sh[0], o1 = v[i].y * rstd * (1.f + sc[1]) + sh[1];
                float o2 = v[i].z * rstd * (1.f + sc[2]) + sh[2], o3 = v[i].w * rstd * (1.f + sc[3]) + sh[3];
                *(uint2*)(h + (size_t)row * 1024 + j) = make_uint2(pack2(o0, o1), pack2(o2, o3));
            }
        }
    }
}

enum { EPI_INPROJ = 0, EPI_UQ = 1, EPI_UKV = 2, EPI_GLU = 3, EPI_OUT = 4 };

template <int EPI>
DEV void gemm_tile(const P& p, int l, const bf16_t* __restrict__ A, int lda, const bf16_t* __restrict__ Bt, int ldb, int K, int m0, int n0, char* smem) {
    char* As = smem;
    char* Bs = smem + 2 * 16384;
    const int tid = ltid(), lane = tid & 63, wave = tid >> 6, wr = wave >> 1, wc = wave & 1;
    f32x4 acc[4][4];
#pragma unroll
    for (int i = 0; i < 4; ++i)
#pragma unroll
        for (int j = 0; j < 4; ++j) acc[i][j] = f32x4{0.f, 0.f, 0.f, 0.f};
    const int srow = wave * 8 + (lane >> 3), schunk = (lane & 7) ^ ((lane >> 3) & 7);
    const bf16_t* Ag = A + (size_t)(m0 + srow) * lda + schunk * 8;
    const bf16_t* Bg = Bt + (size_t)(n0 + srow) * ldb + schunk * 8;
#define G_DMA(buf_, kt_)                                                                                                              \
    {                                                                                                                                 \
        _Pragma("unroll") for (int i = 0; i < 4; ++i) {                                                                               \
            __builtin_amdgcn_global_load_lds((const unsigned*)(Ag + (size_t)(32 * i) * lda + (kt_) * 64),                             \
                                             (unsigned*)(As + (buf_) * 16384 + wave * 1024 + i * 4096), 16, 0, 0);                    \
            __builtin_amdgcn_global_load_lds((const unsigned*)(Bg + (size_t)(32 * i) * ldb + (kt_) * 64),                             \
                                             (unsigned*)(Bs + (buf_) * 16384 + wave * 1024 + i * 4096), 16, 0, 0);                    \
        }                                                                                                                             \
    }
    const int fr = lane & 15, fq = lane >> 4;
    const int nk = K >> 6;
    G_DMA(0, 0)
    __syncthreads();
    for (int kt = 0; kt < nk; ++kt) {
        const int cur = kt & 1;
        if (kt + 1 < nk) G_DMA(cur ^ 1, kt + 1)
        const char* Ac = As + cur * 16384 + (wr * 64 + fr) * 128;
        const char* Bc = Bs + cur * 16384 + (wc * 64 + fr) * 128;
#pragma unroll
        for (int kk = 0; kk < 2; ++kk) {
            const int pc = ((kk * 4 + fq) ^ (fr & 7)) * 16;
            bf16x8 af[4], bfr[4];
#pragma unroll
            for (int i = 0; i < 4; ++i) {
                af[i] = *(const bf16x8*)(Ac + i * 16 * 128 + pc);
                bfr[i] = *(const bf16x8*)(Bc + i * 16 * 128 + pc);
            }
#pragma unroll
            for (int i = 0; i < 4; ++i)
#pragma unroll
                for (int j = 0; j < 4; ++j) acc[i][j] = __builtin_amdgcn_mfma_f32_16x16x32_bf16(bfr[j], af[i], acc[i][j], 0, 0, 0);
        }
        __syncthreads();
    }
#undef G_DMA
    const int rbase = m0 + wr * 64 + (lane & 15);
    const int cbase = n0 + wc * 64 + (lane >> 4) * 4;
    if constexpr (EPI == EPI_INPROJ) {
        float* z = (float*)(p.ws + WS_Z);
        const float* ssq = (const float*)(p.ws + WS_SSQ);
        const float* biasp = (const float*)(p.ws + WS_BIAS) + tok_cond(m0) * ZW;
#pragma unroll
        for (int mi = 0; mi < 4; ++mi) {
            const int row = rbase + mi * 16;
            const int b = row >> 8, t = row & 255;
            const size_t bt = (size_t)((b * 2 + l) * 256 + t);
            float rs = 1.f;
            if (l == 1) {
                float ssum = 0.f;
#pragma unroll
                for (int q = 0; q < 16; ++q) ssum += ssq[q * NTOK + row];
                rs = rsqrtf(ssum * (1.f / 1024.f) + EPS);
            }
#pragma unroll
            for (int ni = 0; ni < 4; ++ni) {
                const int col = cbase + ni * 16;
                float4 v = make_float4(acc[mi][ni][0], acc[mi][ni][1], acc[mi][ni][2], acc[mi][ni][3]);
                if (l == 1) {
                    const float4 bb = *(const float4*)(biasp + col);
                    v = make_float4(v.x * rs + bb.x, v.y * rs + bb.y, v.z * rs + bb.z, v.w * rs + bb.w);
                }
                *(float4*)(z + (size_t)row * ZW + col) = v;
                if (row < NCTX) {
                    if (col >= Z_DAK && col < Z_DAV) *(float4*)(p.out + O_DK + bt * 256 + (col - Z_DAK)) = v;
                    else if (col >= Z_DAV && col < Z_DAG) *(float4*)(p.out + O_DV + bt * 256 + (col - Z_DAV)) = v;
                    else if (col >= Z_KR && col < Z_MLAG) *(float4*)(p.out + O_KR + bt * 32 + (col - Z_KR)) = v;
                }
            }
        }
    } else if constexpr (EPI == EPI_UQ) {
        float* q = (float*)(p.ws + WS_QRAW);
#pragma unroll
        for (int mi = 0; mi < 4; ++mi)
#pragma unroll
            for (int ni = 0; ni < 4; ++ni)
                *(float4*)(q + (size_t)(rbase + mi * 16) * 384 + cbase + ni * 16) = make_float4(acc[mi][ni][0], acc[mi][ni][1], acc[mi][ni][2], acc[mi][ni][3]);
    } else if constexpr (EPI == EPI_UKV) {
        bf16_t* Kmla = (bf16_t*)(p.ws + WS_KMLA);
        bf16_t* VmT = (bf16_t*)(p.ws + WS_VMT);
        int seq = m0 < NCTX ? (m0 >> 8) : 16 + (m0 - NCTX) / 2304;
        int kr0 = seq_kr0(seq), lk = seq_lk(seq);
        size_t vt0 = seq_vt0(seq);
#pragma unroll
        for (int ni = 0; ni < 4; ++ni) {
            int col = cbase + ni * 16, hd = col >> 7, j = col & 127;
#pragma unroll
            for (int mi = 0; mi < 4; ++mi) {
                int row = rbase + mi * 16;
                if (j < 64) {
                    *(uint2*)(Kmla + (size_t)row * 384 + hd * 96 + j) = make_uint2(pack2(acc[mi][ni][0], acc[mi][ni][1]), pack2(acc[mi][ni][2], acc[mi][ni][3]));
                } else {
                    int key = row - kr0;
#pragma unroll
                    for (int r = 0; r < 4; ++r) VmT[vt0 + (size_t)(hd * 64 + (j - 64) + r) * lk + key] = f2bf(acc[mi][ni][r]);
                }
            }
        }
    } else if constexpr (EPI == EPI_GLU) {
        const float* z = (const float*)(p.ws + WS_Z);
        bf16_t* mixed = (bf16_t*)(p.out + 4194304);
#pragma unroll
        for (int np = 0; np < 2; ++np) {
            int colp = n0 + wc * 64 + np * 32;
            int j = (colp >> 5) * 16 + (lane >> 4) * 4;
#pragma unroll
            for (int mi = 0; mi < 4; ++mi) {
                int row = rbase + mi * 16;
                float4 gt = *(const float4*)(z + (size_t)row * ZW + Z_S5G + j);
                float y0 = acc[mi][2 * np][0] * sigmf(acc[mi][2 * np + 1][0]) * siluf(gt.x);
                float y1 = acc[mi][2 * np][1] * sigmf(acc[mi][2 * np + 1][1]) * siluf(gt.y);
                float y2 = acc[mi][2 * np][2] * sigmf(acc[mi][2 * np + 1][2]) * siluf(gt.z);
                float y3 = acc[mi][2 * np][3] * sigmf(acc[mi][2 * np + 1][3]) * siluf(gt.w);
                *(uint2*)(mixed + (size_t)row * 1024 + 256 + j) = make_uint2(pack2(y0, y1), pack2(y2, y3));
            }
        }
    } else if constexpr (EPI == EPI_OUT) {
        const float* mods = (const float*)(p.ws + WS_MODS);
        const float* x1 = (const float*)(p.ws + WS_X1);
        int cond = tok_cond(m0);
        float gate[4][4];
#pragma unroll
        for (int ni = 0; ni < 4; ++ni)
#pragma unroll
            for (int r = 0; r < 4; ++r) gate[ni][r] = mods[(l * 3 + cond) * 3072 + 2048 + cbase + ni * 16 + r];
        float sc1[4][4];
#pragma unroll
        for (int ni = 0; ni < 4; ++ni)
#pragma unroll
            for (int r = 0; r < 4; ++r) sc1[ni][r] = (l == 0) ? 1.f + mods[(3 + cond) * 3072 + 1024 + cbase + ni * 16 + r] : 1.f;
#pragma unroll
        for (int mi = 0; mi < 4; ++mi) {
            int row = rbase + mi * 16;
            const float* xp = (l == 0) ? (row < NCTX ? p.x_prompt + (size_t)row * 1024 : p.x_sample + (size_t)(row - NCTX) * 1024)
                                       : x1 + (size_t)row * 1024;
            float* xn = (l == 0) ? (float*)(p.ws + WS_X1) + (size_t)row * 1024
                                 : (row < NCTX ? (float*)(p.ws + WS_H) + (size_t)row * 1024 : (float*)(p.ws + WS_HGS) + (size_t)(row - NCTX) * 1024);
            float sq = 0.f;
#pragma unroll
            for (int ni = 0; ni < 4; ++ni) {
                int col = cbase + ni * 16;
                float4 xv = *(const float4*)(xp + col);
                const float4 xo = make_float4(xv.x + gate[ni][0] * acc[mi][ni][0], xv.y + gate[ni][1] * acc[mi][ni][1],
                                              xv.z + gate[ni][2] * acc[mi][ni][2], xv.w + gate[ni][3] * acc[mi][ni][3]);
                *(float4*)(xn + col) = xo;
                if (l == 0) {
                    sq += xo.x * xo.x + xo.y * xo.y + xo.z * xo.z + xo.w * xo.w;
                    *(uint2*)((bf16_t*)(p.ws + WS_H) + (size_t)row * 1024 + col) =
                        make_uint2(pack2(xo.x * sc1[ni][0], xo.y * sc1[ni][1]), pack2(xo.z * sc1[ni][2], xo.w * sc1[ni][3]));
                }
            }
            if (l == 0) {
                sq += __shfl_xor(sq, 16);
                sq += __shfl_xor(sq, 32);
                if ((lane >> 4) == 0) ((float*)(p.ws + WS_SSQ))[(size_t)((n0 >> 7) * 2 + wc) * NTOK + row] = sq;
            }
        }
    }
}

DEV void prep_chunk(const P& p, int l, int item, char* smem) {
    bf16_t* vbuf = (bf16_t*)smem;
    const float* z = (const float*)(p.ws + WS_Z);
    const float* tab = (const float*)(p.ws + WS_ROPE);
    bf16_t* Kd = (bf16_t*)(p.ws + WS_KD);
    bf16_t* VdT = (bf16_t*)(p.ws + WS_VDT);
    bf16_t* Kmla = (bf16_t*)(p.ws + WS_KMLA);
    bf16_t* cqn = (bf16_t*)(p.ws + WS_CQN);
    bf16_t* ckvn = (bf16_t*)(p.ws + WS_CKVN);
    const int part = item % 3;
    const int r0 = (item / 3) * 64;
    int seq, key0, tokb = 0, cb = 0, p0 = 0;
    bool cached = false, rope = false;
    if (r0 < NCTX) { seq = r0 >> 8; key0 = r0 & 255; tokb = r0; }
    else {
        int rr = r0 - NCTX; cb = rr / 2304; key0 = rr % 2304; seq = 16 + cb;
        if (key0 < 2048) { tokb = NCTX + cb * 2048 + key0; rope = true; }
        else { cached = true; p0 = key0 - 2048; }
    }
    const int lane = ltid() & 63, wave = ltid() >> 6;
#pragma unroll 4
    for (int i = wave; i < 64; i += 4) {
        const int kr = r0 + i;
        const float *dk, *dv, *krs, *ckv, *cq = nullptr;
        if (!cached) {
            const float* zr = z + (size_t)(tokb + i) * ZW;
            dk = zr + Z_DAK; dv = zr + Z_DAV; krs = zr + Z_KR; ckv = zr + Z_CKV; cq = zr + Z_CQ;
        } else {
            size_t bp = (size_t)((cb * 2 + l) * 256 + p0 + i);
            dk = p.cdk + bp * 256; dv = p.cdv + bp * 256; krs = p.ckrope + bp * 32; ckv = p.cckv + bp * 128;
        }
        const int t = key0 + i;
        if (part == 0) {
            float4 x = ((const float4*)dk)[lane];
            float xs[4] = {x.x, x.y, x.z, x.w};
            float px[4];
#pragma unroll
            for (int e = 0; e < 4; ++e) px[e] = __shfl_xor(xs[e], 2);
            if (rope) {
                int sect = (lane & 7) >> 2;
                int pos = sect ? (t & 63) : (t >> 6);
                bool lo = (lane & 3) < 2;
#pragma unroll
                for (int e = 0; e < 4; ++e) {
                    int f = 4 * (lane & 1) + e;
                    float cs = tab[(pos * 8 + f) * 2], sn = tab[(pos * 8 + f) * 2 + 1];
                    xs[e] = lo ? xs[e] * cs - px[e] * sn : px[e] * sn + xs[e] * cs;
                }
            }
            *(uint2*)(Kd + (size_t)kr * 256 + lane * 4) = make_uint2(pack2(xs[0], xs[1]), pack2(xs[2], xs[3]));
        }
        if (part == 1) {
            float4 x = ((const float4*)dv)[lane];
            *(uint2*)(vbuf + i * 260 + lane * 4) = make_uint2(pack2(x.x, x.y), pack2(x.z, x.w));
        }
        if (part == 2) {
            int l8 = lane & 7;
            float4 x = ((const float4*)krs)[l8];
            float xs[4] = {x.x, x.y, x.z, x.w};
            float px[4];
#pragma unroll
            for (int e = 0; e < 4; ++e) px[e] = __shfl_xor(xs[e], 2);
            if (rope) {
                int sect = l8 >> 2;
                int pos = sect ? (t & 63) : (t >> 6);
                bool lo = (l8 & 3) < 2;
#pragma unroll
                for (int e = 0; e < 4; ++e) {
                    int f = 4 * (l8 & 1) + e;
                    float cs = tab[(pos * 8 + f) * 2], sn = tab[(pos * 8 + f) * 2 + 1];
                    xs[e] = lo ? xs[e] * cs - px[e] * sn : px[e] * sn + xs[e] * cs;
                }
            }
            if (lane < 8) *(uint2*)((bf16_t*)(p.ws + WS_KROPE) + (size_t)kr * 32 + l8 * 4) = make_uint2(pack2(xs[0], xs[1]), pack2(xs[2], xs[3]));
        }
        if (part == 2) {
            float4 x = lane < 32 ? ((const float4*)ckv)[lane] : make_float4(0.f, 0.f, 0.f, 0.f);
            float o0 = x.x, o1 = x.y, o2 = x.z, o3 = x.w;
            if (!cached) {
                float ss = wave_sum(x.x * x.x + x.y * x.y + x.z * x.z + x.w * x.w);
                float rstd = rsqrtf(ss * (1.f / 128.f) + EPS);
                if (lane < 32) {
                    float4 g = ((const float4*)(p.mla_kv_norm + l * 128))[lane];
                    o0 = x.x * rstd * g.x; o1 = x.y * rstd * g.y; o2 = x.z * rstd * g.z; o3 = x.w * rstd * g.w;
                    if (r0 < NCTX) {
                        int b = kr >> 8, tt = kr & 255;
                        *(float4*)(p.out + O_CKV + (size_t)((b * 2 + l) * 256 + tt) * 128 + lane * 4) = make_float4(o0, o1, o2, o3);
                    }
                }
            }
            if (lane < 32) *(uint2*)(ckvn + (size_t)kr * 128 + lane * 4) = make_uint2(pack2(o0, o1), pack2(o2, o3));
        }
        if (part == 2 && !cached) {
            float4 x = lane < 48 ? ((const float4*)cq)[lane] : make_float4(0.f, 0.f, 0.f, 0.f);
            float ss = wave_sum(x.x * x.x + x.y * x.y + x.z * x.z + x.w * x.w);
            float rstd = rsqrtf(ss * (1.f / 192.f) + EPS);
            if (lane < 48) {
                float4 g = ((const float4*)(p.mla_q_norm + l * 192))[lane];
                *(uint2*)(cqn + (size_t)(tokb + i) * 192 + lane * 4) =
                    make_uint2(pack2(x.x * rstd * g.x, x.y * rstd * g.y), pack2(x.z * rstd * g.z, x.w * rstd * g.w));
            }
        }
    }
    if (part != 1) return;
    __syncthreads();
    {
        const int c = ltid(), lk = seq_lk(seq);
        bf16_t* dst = VdT + seq_vt0(seq) + (size_t)c * lk + key0;
#pragma unroll
        for (int q = 0; q < 8; ++q) {
            uint32_t w[4];
#pragma unroll
            for (int e = 0; e < 4; ++e) w[e] = (uint32_t)vbuf[(q * 8 + 2 * e) * 260 + c] | ((uint32_t)vbuf[(q * 8 + 2 * e + 1) * 260 + c] << 16);
            *(uint4*)(dst + q * 8) = make_uint4(w[0], w[1], w[2], w[3]);
        }
    }
    __syncthreads();
}

DEV void s5_params(const P& p, int l, int dir, int g, int lane, float& abr, float& abi, float (&bbr)[16], float (&bbi)[16]) {
    const int ldg = (l * 2 + dir) * 16 + g;
    float step = expf(p.s5_log_dt[ldg]);
    float are = p.s5_a_re[ldg * 64 + lane], aim = p.s5_a_im[ldg * 64 + lane];
    float mag = expf(are * step);
    float ang = aim * step;
    abr = mag * cosf(ang);
    abi = mag * sinf(ang);
    float den = are * are + aim * aim;
    float fre = ((abr - 1.f) * are + abi * aim) / den, fim = (abi * are - (abr - 1.f) * aim) / den;
    const float4* br = (const float4*)(p.s5_b_re + (size_t)(ldg * 64 + lane) * 16);
    const float4* bi = (const float4*)(p.s5_b_im + (size_t)(ldg * 64 + lane) * 16);
#pragma unroll
    for (int q = 0; q < 4; ++q) {
        float4 r = br[q], im = bi[q];
        bbr[4 * q + 0] = fre * r.x - fim * im.x; bbi[4 * q + 0] = fre * im.x + fim * r.x;
        bbr[4 * q + 1] = fre * r.y - fim * im.y; bbi[4 * q + 1] = fre * im.y + fim * r.y;
        bbr[4 * q + 2] = fre * r.z - fim * im.z; bbi[4 * q + 2] = fre * im.z + fim * r.z;
        bbr[4 * q + 3] = fre * r.w - fim * im.w; bbi[4 * q + 3] = fre * im.w + fim * r.w;
    }
}
DEV void s5_bu8(const float* ubuf, int sb, int dir, const float (&bbr)[16], const float (&bbi)[16], float (&bur)[8], float (&bui)[8]) {
#pragma unroll
    for (int ii = 0; ii < 8; ++ii) {
        const int i = dir ? 7 - ii : ii;
        const float4* up = (const float4*)(ubuf + (sb * 8 + i) * 16);
        float4 u0 = up[0], u1 = up[1], u2 = up[2], u3 = up[3];
        float r0 = bbr[0] * u0.x, r1 = bbr[1] * u0.y, i0 = bbi[0] * u0.x, i1 = bbi[1] * u0.y;
        r0 += bbr[2] * u0.z; r1 += bbr[3] * u0.w; i0 += bbi[2] * u0.z; i1 += bbi[3] * u0.w;
        r0 += bbr[4] * u1.x; r1 += bbr[5] * u1.y; i0 += bbi[4] * u1.x; i1 += bbi[5] * u1.y;
        r0 += bbr[6] * u1.z; r1 += bbr[7] * u1.w; i0 += bbi[6] * u1.z; i1 += bbi[7] * u1.w;
        r0 += bbr[8] * u2.x; r1 += bbr[9] * u2.y; i0 += bbi[8] * u2.x; i1 += bbi[9] * u2.y;
        r0 += bbr[10] * u2.z; r1 += bbr[11] * u2.w; i0 += bbi[10] * u2.z; i1 += bbi[11] * u2.w;
        r0 += bbr[12] * u3.x; r1 += bbr[13] * u3.y; i0 += bbi[12] * u3.x; i1 += bbi[13] * u3.y;
        r0 += bbr[14] * u3.z; r1 += bbr[15] * u3.w; i0 += bbi[14] * u3.z; i1 += bbi[15] * u3.w;
        bur[ii] = r0 + r1; bui[ii] = i0 + i1;
    }
}
DEV void s5_stage_u(const float* __restrict__ z, int tok0, int g, int lane, float* ubuf) {
    float4 v[4];
#pragma unroll
    for (int k = 0; k < 4; ++k) v[k] = *(const float4*)(z + (size_t)(tok0 + (lane >> 2) + 16 * k) * ZW + Z_S5U + g * 16 + (lane & 3) * 4);
#pragma unroll
    for (int k = 0; k < 4; ++k) *(float4*)(ubuf + ((lane >> 2) + 16 * k) * 16 + (lane & 3) * 4) = v[k];
    __builtin_amdgcn_wave_barrier();
    asm volatile("s_waitcnt lgkmcnt(0)" ::: "memory");
}
DEV void s5a_wave(const P& p, int l, int witem, char* smem_wave) {
    float* ubuf = (float*)smem_wave;
    const int lane = ltid() & 63;
    const int g = witem & 15, dir = (witem >> 4) & 1, gc = witem >> 5;
    float abr, abi, bbr[16], bbi[16];
    s5_params(p, l, dir, g, lane, abr, abi, bbr, bbi);
    const float* z = (const float*)(p.ws + WS_Z);
    const int tok0 = gc * 64;
    s5_stage_u(z, tok0, g, lane, ubuf);
    float hr = 0.f, hi = 0.f;
#pragma unroll 2
    for (int sbi = 0; sbi < 8; ++sbi) {
        const int sb = dir ? 7 - sbi : sbi;
        float bur[8], bui[8];
        s5_bu8(ubuf, sb, dir, bbr, bbi, bur, bui);
#pragma unroll
        for (int ii = 0; ii < 8; ++ii) {
            float nr = abr * hr - abi * hi + bur[ii], ni = abr * hi + abi * hr + bui[ii];
            hr = nr; hi = ni;
        }
    }
    float2* F = (float2*)(p.ws + WS_S5F);
    F[(size_t)((gc * 2 + dir) * 16 + g) * 64 + lane] = make_float2(hr, hi);
    __builtin_amdgcn_wave_barrier();
}
constexpr int S5H = 132;
constexpr int S5B_LDS = (64 * 16 + 16 * S5H) * 4;
DEV void s5_split8(const float4 a, const float4 b, bf16x8& hi, bf16x8& lo) {
    const float x[8] = {a.x, a.y, a.z, a.w, b.x, b.y, b.z, b.w};
    union { bf16x8 v; uint32_t u[4]; } H, L;
#pragma unroll
    for (int j = 0; j < 4; ++j) {
        const uint32_t h = pack2(x[2 * j], x[2 * j + 1]);
        const float h0 = __uint_as_float(h << 16), h1 = __uint_as_float(h & 0xffff0000u);
        H.u[j] = h;
        L.u[j] = pack2(x[2 * j] - h0, x[2 * j + 1] - h1);
    }
    hi = H.v; lo = L.v;
}
DEV void s5b_wave(const P& p, int l, int witem, char* smem_wave) {
    float* ubuf = (float*)smem_wave;
    float* hb = ubuf + 64 * 16;
    const int lane = ltid() & 63;
    const int g = witem & 15, gc = witem >> 4;
    const int tok0 = gc * 64;
    const int seq = tok_seq(tok0);
    const int nch = seq < 16 ? 4 : 32;
    const int gcb = seq < 16 ? seq * 4 : 64 + (seq - 16) * 32;
    const int cis = gc - gcb;
    const float* z = (const float*)(p.ws + WS_Z);
    const float2* F = (const float2*)(p.ws + WS_S5F);
    s5_stage_u(z, tok0, g, lane, ubuf);
    float* yp = (float*)(p.ws + WS_YP);
    bf16_t* gy = (bf16_t*)(p.ws + WS_GY);
    const int ch = lane & 15, kg = lane >> 4;
    const float dch = p.s5_d[l * 256 + g * 16 + ch];
#pragma nounroll
    for (int dir = 0; dir < 2; ++dir) {
        float abr, abi, bbr[16], bbi[16];
        s5_params(p, l, dir, g, lane, abr, abi, bbr, bbi);
        float pr = abr, pi = abi;
#pragma unroll
        for (int s = 0; s < 6; ++s) { float nr = pr * pr - pi * pi, ni = 2.f * pr * pi; pr = nr; pi = ni; }
        float hr = 0.f, hi = 0.f;
        if (seq >= 16) {
            const float* h0 = p.st_s5 + ((size_t)((((seq - 16) * 2 + l) * 2 + dir) * 16 + g) * 64 + lane) * 2;
            hr = h0[0]; hi = h0[1];
        }
        const int nprior = dir ? (nch - 1 - cis) : cis;
#pragma unroll 4
        for (int j = 0; j < nprior; ++j) {
            int c = dir ? (nch - 1 - j) : j;
            float2 f = F[(size_t)(((gcb + c) * 2 + dir) * 16 + g) * 64 + lane];
            float nr = pr * hr - pi * hi + f.x, ni = pr * hi + pi * hr + f.y;
            hr = nr; hi = ni;
        }
        bf16x8 chi[4], clo[4];
        {
            const float* cr = p.s5_c_re + (size_t)((l * 2 + dir) * 16 + g) * 16 * 64 + ch * 64;
            const float* ci = p.s5_c_im + (size_t)((l * 2 + dir) * 16 + g) * 16 * 64 + ch * 64;
#pragma unroll
            for (int s = 0; s < 4; ++s) {
                const float* src = (s < 2 ? cr : ci) + 32 * (s & 1) + 8 * kg;
                float4 a = *(const float4*)src, b = *(const float4*)(src + 4);
                if (s >= 2) { a.x = -a.x; a.y = -a.y; a.z = -a.z; a.w = -a.w; b.x = -b.x; b.y = -b.y; b.z = -b.z; b.w = -b.w; }
                s5_split8(a, b, chi[s], clo[s]);
            }
        }
#pragma nounroll
        for (int sbi = 0; sbi < 4; ++sbi) {
            const int sb = dir ? 3 - sbi : sbi;
#pragma nounroll
            for (int half = 0; half < 2; ++half) {
                const int h8 = dir ? 1 - half : half;
                float bur[8], bui[8];
                s5_bu8(ubuf, sb * 2 + h8, dir, bbr, bbi, bur, bui);
#pragma unroll
                for (int ii = 0; ii < 8; ++ii) {
                    const int i = h8 * 8 + (dir ? 7 - ii : ii);
                    float nr = abr * hr - abi * hi + bur[ii], ni = abr * hi + abi * hr + bui[ii];
                    hr = nr; hi = ni;
                    hb[i * S5H + lane] = hr;
                    hb[i * S5H + 64 + lane] = hi;
                }
            }
            __builtin_amdgcn_wave_barrier();
            asm volatile("s_waitcnt lgkmcnt(0)" ::: "memory");
            f32x4 acc = {0.f, 0.f, 0.f, 0.f};
#pragma unroll
            for (int s = 0; s < 4; ++s) {
                const float* hp = hb + (lane & 15) * S5H + 32 * s + 8 * kg;
                bf16x8 ahi, alo;
                s5_split8(*(const float4*)hp, *(const float4*)(hp + 4), ahi, alo);
                acc = __builtin_amdgcn_mfma_f32_16x16x32_bf16(ahi, chi[s], acc, 0, 0, 0);
                acc = __builtin_amdgcn_mfma_f32_16x16x32_bf16(ahi, clo[s], acc, 0, 0, 0);
                acc = __builtin_amdgcn_mfma_f32_16x16x32_bf16(alo, chi[s], acc, 0, 0, 0);
            }
#pragma unroll
            for (int r = 0; r < 4; ++r) {
                const int tl = sb * 16 + kg * 4 + r;
                float* ypp = yp + ((size_t)g * NTOK + tok0 + tl) * 16 + ch;
                if (dir == 0) {
                    *ypp = acc[r];
                } else {
                    const float y0 = __hip_atomic_load(ypp, __ATOMIC_RELAXED, __HIP_MEMORY_SCOPE_AGENT);
                    const float u = ubuf[tl * 16 + ch];
                    gy[(size_t)(tok0 + tl) * 256 + g * 16 + ch] = f2bf(geluf(y0 + acc[r] + dch * u));
                }
            }
            __builtin_amdgcn_wave_barrier();
            asm volatile("s_waitcnt lgkmcnt(0)" ::: "memory");
        }
        asm volatile("s_waitcnt vmcnt(0)" ::: "memory");
        if (seq < 16 && cis == (dir ? 0 : nch - 1)) {
            float* o = p.out + O_S5 + ((size_t)(((seq * 2 + l) * 2 + dir) * 16 + g) * 64 + lane) * 2;
            o[0] = hr; o[1] = hi;
        }
    }
    __builtin_amdgcn_wave_barrier();
    asm volatile("s_waitcnt lgkmcnt(0)" ::: "memory");
}

constexpr int HS = 68;
DEV void hg_load(const P& p, int l, int gc, int hd, int dir, float* qq, float* kk, float* bq, bool want_q) {
    const float* z = (const float*)(p.ws + WS_Z);
    const int tid = ltid(), d = tid & 63, rq = tid >> 6;
    float lb = 0.f;
    if (l > 0) {
        float e0 = expf(p.hg_lb[(0 * 2 + dir) * 256 + hd * 64 + d]), e1 = expf(p.hg_lb[(1 * 2 + dir) * 256 + hd * 64 + d]);
        lb = e1 / (e0 + e1);
    }
    const int zf = dir ? Z_HGFB : Z_HGFF;
    {
        float zz[16], qv[16];
#pragma unroll
        for (int k = 0; k < 16; ++k) {
            int i = rq + 4 * k;
            int tok = gc * 64 + (dir ? 63 - i : i);
            const float* zr = z + (size_t)tok * ZW;
            zz[k] = zr[zf + hd * 64 + d];
            qv[k] = want_q ? zr[Z_HGQ + hd * 64 + d] : 0.f;
        }
#pragma unroll
        for (int k = 0; k < 16; ++k) {
            int i = rq + 4 * k;
            float sg = sigmf(zz[k]);
            bq[d * HS + i] = __logf(lb + (1.f - lb) * sg);
            kk[d * HS + i] = (1.f - lb) * sigmf(-zz[k]);
            if (want_q) qq[d * HS + i] = qv[k];
        }
    }
    __syncthreads();
    float v[16];
    {
        const float4* src = (const float4*)(bq + d * HS + rq * 16);
        float4 a0 = src[0], a1 = src[1], a2 = src[2], a3 = src[3];
        float t[16] = {a0.x, a0.y, a0.z, a0.w, a1.x, a1.y, a1.z, a1.w, a2.x, a2.y, a2.z, a2.w, a3.x, a3.y, a3.z, a3.w};
        float run = 0.f;
#pragma unroll
        for (int k = 0; k < 16; ++k) { run += t[k]; v[k] = run; }
    }
    bq[d * HS + rq * 16 + 15] = v[15];
    __syncthreads();
    float off = 0.f;
#pragma unroll
    for (int q = 0; q < 3; ++q) off += (q < rq) ? bq[d * HS + q * 16 + 15] : 0.f;
    __syncthreads();
    {
        float4* dst = (float4*)(bq + d * HS + rq * 16);
        dst[0] = make_float4(v[0] + off, v[1] + off, v[2] + off, v[3] + off);
        dst[1] = make_float4(v[4] + off, v[5] + off, v[6] + off, v[7] + off);
        dst[2] = make_float4(v[8] + off, v[9] + off, v[10] + off, v[11] + off);
        dst[3] = make_float4(v[12] + off, v[13] + off, v[14] + off, v[15] + off);
    }
    __syncthreads();
}
DEV void hga_block(const P& p, int l, int item, char* smem) {
    float* kk = (float*)smem;
    float* bq = kk + 64 * HS;
    float* vv = bq + 64 * HS;
    const int dir = item & 1, hd = (item >> 1) & 3, gc = item >> 3;
    const float* z = (const float*)(p.ws + WS_Z);
    const int tid = ltid();
    __syncthreads();
    {
        const int vq = (tid & 15) * 4, i0 = tid >> 4;
#pragma unroll
        for (int k = 0; k < 4; ++k) {
            int i = i0 + 16 * k;
            int tok = gc * 64 + (dir ? 63 - i : i);
            *(float4*)(vv + i * 64 + vq) = *(const float4*)(z + (size_t)tok * ZW + Z_HGI + hd * 64 + vq);
        }
    }
    hg_load(p, l, gc, hd, dir, nullptr, kk, bq, false);
    {
        const int d = tid & 63, rq = tid >> 6;
        const float bl = bq[d * HS + 63];
        float4* kp = (float4*)(kk + d * HS + rq * 16);
        const float4* bp = (const float4*)(bq + d * HS + rq * 16);
#pragma unroll
        for (int k = 0; k < 4; ++k) {
            float4 kv = kp[k], bv = bp[k];
            kv.x *= __expf(bl - bv.x); kv.y *= __expf(bl - bv.y); kv.z *= __expf(bl - bv.z); kv.w *= __expf(bl - bv.w);
            kp[k] = kv;
        }
    }
    __syncthreads();
    float* S = (float*)(p.ws + WS_HGS) + (size_t)item * 4096;
    float* Dd = (float*)(p.ws + WS_HGD) + (size_t)item * 64;
    if (tid < 64) Dd[tid] = __expf(bq[tid * HS + 63]);
    const int db = (tid >> 4) * 4, vb = (tid & 15) * 4;
    float acc[4][4];
#pragma unroll
    for (int a = 0; a < 4; ++a)
#pragma unroll
        for (int b = 0; b < 4; ++b) acc[a][b] = 0.f;
#pragma unroll 2
    for (int i = 0; i < 64; i += 4) {
        float4 kd[4], v4[4];
#pragma unroll
        for (int a = 0; a < 4; ++a) kd[a] = *(const float4*)(kk + (db + a) * HS + i);
#pragma unroll
        for (int ii = 0; ii < 4; ++ii) v4[ii] = *(const float4*)(vv + (i + ii) * 64 + vb);
#pragma unroll
        for (int a = 0; a < 4; ++a) {
            const float ka[4] = {kd[a].x, kd[a].y, kd[a].z, kd[a].w};
#pragma unroll
            for (int ii = 0; ii < 4; ++ii) {
                acc[a][0] += ka[ii] * v4[ii].x; acc[a][1] += ka[ii] * v4[ii].y; acc[a][2] += ka[ii] * v4[ii].z; acc[a][3] += ka[ii] * v4[ii].w;
            }
        }
    }
#pragma unroll
    for (int a = 0; a < 4; ++a) *(float4*)(S + (db + a) * 64 + vb) = make_float4(acc[a][0], acc[a][1], acc[a][2], acc[a][3]);
    __syncthreads();
}
DEV void hgc_block(const P& p, int l, int item) {
    const int chain = item >> 4, sl = item & 15;
    const int dir = chain & 1, hd = (chain >> 1) & 3, seq = chain >> 3;
    const int e = sl * 256 + ltid();
    const int nch = seq < 16 ? 4 : 32, gcb = seq < 16 ? seq * 4 : 64 + (seq - 16) * 32;
    const float* Sb = (const float*)(p.ws + WS_HGS);
    float* Sn = p.out + O_YP;
    const float* Db = (const float*)(p.ws + WS_HGD);
    float S = 0.f;
    if (seq >= 16) S = p.st_hg[(size_t)((((seq - 16) * 2 + l) * 2 + dir) * 4 + hd) * 4096 + e];
    for (int c0 = 0; c0 < nch; c0 += 4) {
        float dS[4], Dv[4];
        size_t its[4];
#pragma unroll
        for (int k = 0; k < 4; ++k) {
            int c = dir ? nch - 1 - (c0 + k) : c0 + k;
            its[k] = (size_t)((gcb + c) * 4 + hd) * 2 + dir;
            dS[k] = Sb[its[k] * 4096 + e];
            Dv[k] = Db[its[k] * 64 + (e >> 6)];
        }
#pragma unroll
        for (int k = 0; k < 4; ++k) {
            Sn[its[k] * 4096 + e] = S;
            S = S * Dv[k] + dS[k];
        }
    }
    if (seq < 16) p.out[O_HG + (size_t)(((seq * 2 + l) * 2 + dir) * 4 + hd) * 4096 + e] = S;
}
DEV void hgb_block(const P& p, int l, int item, char* smem) {
    float* qq = (float*)smem;
    float* kk = qq + 64 * HS;
    float* bq = kk + 64 * HS;
    float* sc = bq + 64 * HS;
    const int hd = item & 3, gc = item >> 2;
    const float* z = (const float*)(p.ws + WS_Z);
    const int tid = ltid();
    __syncthreads();
    const int tb = (tid >> 4) * 4, vb = (tid & 15) * 4;
    float o[4][4];
#pragma unroll
    for (int a = 0; a < 4; ++a)
#pragma unroll
        for (int b = 0; b < 4; ++b) o[a][b] = 0.f;
#pragma nounroll
    for (int dir = 0; dir < 2; ++dir) {
        hg_load(p, l, gc, hd, dir, qq, kk, bq, true);
        const float* Sin = (const float*)(p.out + O_YP) + (size_t)((gc * 4 + hd) * 2 + dir) * 4096;
        const int pvq = (tid & 15) * 4, pr0 = tid >> 4;
#define HG_PF(k_, pvk_, psk_)                                                                     \
        {                                                                                             \
            const int i_ = pr0 + 16 * (k_);                                                           \
            const int tok_ = gc * 64 + (dir ? 63 - i_ : i_);                                          \
            pvk_ = *(const float4*)(z + (size_t)tok_ * ZW + Z_HGI + hd * 64 + pvq);                   \
            psk_ = *(const float4*)(Sin + i_ * 64 + pvq);                                             \
        }
        float4 pv0, pv1, pv2, pv3, ps0, ps1, ps2, ps3;
        HG_PF(0, pv0, ps0) HG_PF(1, pv1, ps1) HG_PF(2, pv2, ps2) HG_PF(3, pv3, ps3)
        {
            const int ib = (tid >> 4) * 4, sbk = (tid & 15) * 4;
            float a[4][4];
#pragma unroll
            for (int x = 0; x < 4; ++x)
#pragma unroll
                for (int y = 0; y < 4; ++y) a[x][y] = 0.f;
            if (sbk < ib) {
#pragma unroll 2
                for (int d = 0; d < 64; ++d) {
                    const float4 qi = *(const float4*)(qq + d * HS + ib), bi = *(const float4*)(bq + d * HS + ib);
                    const float4 ks = *(const float4*)(kk + d * HS + sbk), bs = *(const float4*)(bq + d * HS + sbk);
                    const float br = bi.x;
                    const float qe[4] = {qi.x, qi.y * __expf(bi.y - br), qi.z * __expf(bi.z - br), qi.w * __expf(bi.w - br)};
                    const float kf[4] = {ks.x * __expf(br - bs.x), ks.y * __expf(br - bs.y), ks.z * __expf(br - bs.z), ks.w * __expf(br - bs.w)};
#pragma unroll
                    for (int x = 0; x < 4; ++x)
#pragma unroll
                        for (int y = 0; y < 4; ++y) a[x][y] += qe[x] * kf[y];
                }
            } else if (sbk == ib) {
#pragma unroll 2
                for (int d = 0; d < 64; ++d) {
                    const float4 qi = *(const float4*)(qq + d * HS + ib), bi = *(const float4*)(bq + d * HS + ib);
                    const float4 ks = *(const float4*)(kk + d * HS + sbk);
                    const float qx[4] = {qi.x, qi.y, qi.z, qi.w}, bx[4] = {bi.x, bi.y, bi.z, bi.w}, ky[4] = {ks.x, ks.y, ks.z, ks.w};
#pragma unroll
                    for (int x = 0; x < 4; ++x)
#pragma unroll
                        for (int y = 0; y < 4; ++y)
                            if (y <= x) a[x][y] += qx[x] * ky[y] * __expf(bx[x] - bx[y]);
                }
            }
#pragma unroll
            for (int y = 0; y < 4; ++y) *(float4*)(sc + (sbk + y) * HS + ib) = make_float4(a[0][y], a[1][y], a[2][y], a[3][y]);
        }
        __syncthreads();
        float* vt_ = kk;
        float* st_ = bq;
        *(float4*)(vt_ + (pr0 + 0) * 64 + pvq) = pv0; *(float4*)(vt_ + (pr0 + 16) * 64 + pvq) = pv1;
        *(float4*)(vt_ + (pr0 + 32) * 64 + pvq) = pv2; *(float4*)(vt_ + (pr0 + 48) * 64 + pvq) = pv3;
        {
            const int d = tid & 63, rq = tid >> 6;
            float4* qp = (float4*)(qq + d * HS + rq * 16);
            const float4* bp = (const float4*)(bq + d * HS + rq * 16);
#pragma unroll
            for (int k = 0; k < 4; ++k) {
                float4 qv = qp[k], bv = bp[k];
                qv.x *= __expf(bv.x); qv.y *= __expf(bv.y); qv.z *= __expf(bv.z); qv.w *= __expf(bv.w);
                qp[k] = qv;
            }
        }
        __syncthreads();
        *(float4*)(st_ + (pr0 + 0) * 64 + pvq) = ps0; *(float4*)(st_ + (pr0 + 16) * 64 + pvq) = ps1;
        *(float4*)(st_ + (pr0 + 32) * 64 + pvq) = ps2; *(float4*)(st_ + (pr0 + 48) * 64 + pvq) = ps3;
        __syncthreads();
        const int i0 = dir ? 60 - tb : tb;
#pragma unroll 4
        for (int s = 0; s < 64; ++s) {
            const float4 v4 = *(const float4*)(vt_ + s * 64 + vb);
            const float4 s4 = *(const float4*)(st_ + s * 64 + vb);
            const float4 w4 = *(const float4*)(sc + s * HS + i0);
            const float4 q4 = *(const float4*)(qq + s * HS + i0);
            const float w[4] = {dir ? w4.w : w4.x, dir ? w4.z : w4.y, dir ? w4.y : w4.z, dir ? w4.x : w4.w};
            const float qe[4] = {dir ? q4.w : q4.x, dir ? q4.z : q4.y, dir ? q4.y : q4.z, dir ? q4.x : q4.w};
#pragma unroll
            for (int x = 0; x < 4; ++x) {
                o[x][0] += w[x] * v4.x + qe[x] * s4.x;
                o[x][1] += w[x] * v4.y + qe[x] * s4.y;
                o[x][2] += w[x] * v4.z + qe[x] * s4.z;
                o[x][3] += w[x] * v4.w + qe[x] * s4.w;
            }
        }
        __syncthreads();
    }
    bf16_t* mixed = (bf16_t*)(p.out + 4194304);
    const float4 g4 = *(const float4*)(p.hg_norm + l * 64 + vb);
#pragma unroll
    for (int x = 0; x < 4; ++x) {
        float ss = o[x][0] * o[x][0] + o[x][1] * o[x][1] + o[x][2] * o[x][2] + o[x][3] * o[x][3];
        ss += __shfl_xor(ss, 1); ss += __shfl_xor(ss, 2); ss += __shfl_xor(ss, 4); ss += __shfl_xor(ss, 8);
        float rstd = rsqrtf(ss * (1.f / 64.f) + EPS);
        int tok = gc * 64 + tb + x;
        float4 gt = *(const float4*)(z + (size_t)tok * ZW + Z_HGG + hd * 64 + vb);
        float y0 = o[x][0] * rstd * g4.x * siluf(gt.x), y1 = o[x][1] * rstd * g4.y * siluf(gt.y);
        float y2 = o[x][2] * rstd * g4.z * siluf(gt.z), y3 = o[x][3] * rstd * g4.w * siluf(gt.w);
        *(uint2*)(mixed + (size_t)tok * 1024 + 512 + hd * 64 + vb) = make_uint2(pack2(y0, y1), pack2(y2, y3));
    }
}

constexpr float ATT_THR = 5.0f;
template <int NC, int NDS>
DEV void attn_block(const float* __restrict__ qsrc, int qstride, const bf16_t* __restrict__ kbase, int kstride, const bf16_t* __restrict__ vt,
                    int Lk, const float* __restrict__ tab, bool rope, int t0, float qscale, float lam, float post,
                    const float* __restrict__ norm_g, const float* __restrict__ gate, bf16_t* __restrict__ outp, char* smem,
                    const bf16_t* __restrict__ krope) {
    constexpr int KW = NC * NDS * 16;
    constexpr int KP = KW + 8;
    constexpr int RC = KW / 8;
    constexpr int NKC = (64 * RC) / 256;
    constexpr int KS_STAGE = 64 * KP;
    constexpr int VS_STAGE = 64 * 72;
    bf16_t* Ks = (bf16_t*)smem;
    bf16_t* Vs = Ks + 2 * KS_STAGE;
    const int tid = ltid(), lane = tid & 63, wave = tid >> 6, r = lane & 31, hh = lane >> 5;
    __syncthreads();
    bf16x8 qf[NC][NDS];
    {
        const float* qs = qsrc + (size_t)(wave * 32 + r) * qstride;
#pragma unroll
        for (int c = 0; c < NC; ++c)
#pragma unroll
            for (int ds = 0; ds < NDS; ++ds) {
                const float* s = qs + (c * NDS + ds) * 16 + 8 * hh;
                float4 a = *(const float4*)s, b = *(const float4*)(s + 4);
                float x[8] = {a.x, a.y, a.z, a.w, b.x, b.y, b.z, b.w};
                if (ds >= NDS - 2) {
                    float px[8];
#pragma unroll
                    for (int j = 0; j < 8; ++j) px[j] = __shfl_xor(x[j], 32);
                    if (rope) {
                        int t = t0 + wave * 32 + r;
                        int pos = (ds == NDS - 2) ? (t >> 6) : (t & 63);
#pragma unroll
                        for (int j = 0; j < 8; ++j) {
                            float cs = tab[(pos * 8 + j) * 2], sn = tab[(pos * 8 + j) * 2 + 1];
                            x[j] = hh == 0 ? x[j] * cs - px[j] * sn : px[j] * sn + x[j] * cs;
                        }
                    }
                }
                union { bf16x8 v; uint32_t u[4]; } pk;
#pragma unroll
                for (int j = 0; j < 4; ++j) pk.u[j] = pack2(x[2 * j] * qscale, x[2 * j + 1] * qscale);
                qf[c][ds] = pk.v;
            }
    }
    f32x16 O[NC][2];
    float m[NC], ls[NC];
#pragma unroll
    for (int c = 0; c < NC; ++c) {
        m[c] = -1e30f; ls[c] = 0.f;
#pragma unroll
        for (int e = 0; e < 16; ++e) { O[c][0][e] = 0.f; O[c][1][e] = 0.f; }
    }
    uint4 rk[NKC], rv[2];
    const int vrow = tid >> 3, vcc = tid & 7;
#define ATT_GLOAD(key0_)                                                                                                         \
    {                                                                                                                            \
        _Pragma("unroll") for (int i = 0; i < NKC; ++i) {                                                                        \
            int c = tid + 256 * i;                                                                                               \
            const int cc_ = c % RC, row_ = (key0_) + c / RC;                                                                     \
            rk[i] = (RC <= 8 || cc_ < 8) ? *(const uint4*)(kbase + (size_t)row_ * kstride + cc_ * 8)                            \
                                         : *(const uint4*)(krope + (size_t)row_ * 32 + (cc_ - 8) * 8);                          \
        }                                                                                                                        \
        _Pragma("unroll") for (int i = 0; i < 2; ++i) rv[i] = *(const uint4*)(vt + (size_t)(vrow + 32 * i) * Lk + (key0_) + vcc * 8); \
    }
#define ATT_SWRITE(buf_)                                                                                                         \
    {                                                                                                                            \
        _Pragma("unroll") for (int i = 0; i < NKC; ++i) {                                                                        \
            int c = tid + 256 * i;                                                                                               \
            *(uint4*)(Ks + (buf_) * KS_STAGE + (c / RC) * KP + (c % RC) * 8) = rk[i];                                            \
        }                                                                                                                        \
        _Pragma("unroll") for (int i = 0; i < 2; ++i) *(uint4*)(Vs + (buf_) * VS_STAGE + (vrow + 32 * i) * 72 + vcc * 8) = rv[i]; \
    }
    ATT_GLOAD(0)
    ATT_SWRITE(0)
    __syncthreads();
    const int nt = Lk >> 6;
    for (int kt = 0; kt < nt; ++kt) {
        const int cur = kt & 1;
        if (kt + 1 < nt) ATT_GLOAD((kt + 1) * 64)
        const bf16_t* Kc = Ks + cur * KS_STAGE + r * KP + 8 * hh;
        const bf16_t* Vc = Vs + cur * VS_STAGE + r * 72 + 4 * hh;
        constexpr int NSTEP = 2 * NC;
        f32x16 Sb[2];
        bf16x8 vf[2][2];
#define ATT_QK(step_, dst_)                                                                                          \
        {                                                                                                            \
            const int sub_ = (step_) / NC, c_ = (step_) % NC;                                                        \
            _Pragma("unroll") for (int e = 0; e < 16; ++e) dst_[e] = 0.f;                                            \
            _Pragma("unroll") for (int ds = 0; ds < NDS; ++ds) {                                                     \
                bf16x8 kf = *(const bf16x8*)(Kc + sub_ * 32 * KP + (c_ * NDS + ds) * 16);                            \
                dst_ = __builtin_amdgcn_mfma_f32_32x32x16_bf16(kf, qf[c_][ds], dst_, 0, 0, 0);                       \
            }                                                                                                        \
        }
        ATT_QK(0, Sb[0])
#pragma unroll
        for (int step = 0; step < NSTEP; ++step) {
            const int sub = step / NC, c = step % NC;
            if (step + 1 < NSTEP) ATT_QK(step + 1, Sb[(step + 1) & 1])
            if (c == 0) {
#pragma unroll
                for (int dvb = 0; dvb < 2; ++dvb)
#pragma unroll
                    for (int s = 0; s < 2; ++s) {
                        const bf16_t* vp = Vc + dvb * 32 * 72 + sub * 32 + 16 * s;
                        uint2 lo = *(const uint2*)vp, hi = *(const uint2*)(vp + 8);
                        union { bf16x8 v; uint32_t u[4]; } pk;
                        pk.u[0] = lo.x; pk.u[1] = lo.y; pk.u[2] = hi.x; pk.u[3] = hi.y;
                        vf[dvb][s] = pk.v;
                    }
            }
            f32x16 S = Sb[step & 1];
            float mx = S[0];
#pragma unroll
            for (int e = 1; e < 16; ++e) mx = fmaxf(mx, S[e]);
            {
                const auto sw = __builtin_amdgcn_permlane32_swap(__float_as_uint(mx), __float_as_uint(mx), false, false);
                mx = fmaxf(__uint_as_float(sw[0]), __uint_as_float(sw[1]));
            }
            if (__builtin_amdgcn_ballot_w64(mx - m[c] > ATT_THR) != 0ull) {
                const float mn = fmaxf(m[c], mx);
                const float alpha = __builtin_amdgcn_exp2f(m[c] - mn);
                m[c] = mn;
                ls[c] *= alpha;
#pragma unroll
                for (int e = 0; e < 16; ++e) { O[c][0][e] *= alpha; O[c][1][e] *= alpha; }
            }
            const float mcur = m[c];
            float rs = 0.f;
#pragma unroll
            for (int e = 0; e < 16; ++e) { S[e] = __builtin_amdgcn_exp2f(S[e] - mcur); rs += S[e]; }
            ls[c] += rs;
#pragma unroll
            for (int s = 0; s < 2; ++s) {
                union { bf16x8 v; uint32_t u[4]; } pk;
#pragma unroll
                for (int j = 0; j < 4; ++j) pk.u[j] = pack2(S[8 * s + 2 * j], S[8 * s + 2 * j + 1]);
                O[c][0] = __builtin_amdgcn_mfma_f32_32x32x16_bf16(vf[0][s], pk.v, O[c][0], 0, 0, 0);
                O[c][1] = __builtin_amdgcn_mfma_f32_32x32x16_bf16(vf[1][s], pk.v, O[c][1], 0, 0, 0);
            }
        }
#undef ATT_QK
        if (kt + 1 < nt) ATT_SWRITE(cur ^ 1)
        __syncthreads();
    }
    float inv[NC];
#pragma unroll
    for (int c = 0; c < NC; ++c) { float lt = ls[c] + __shfl_xor(ls[c], 32); inv[c] = 1.f / lt; }
    float o[2][16];
    float ss = 0.f;
#pragma unroll
    for (int dvb = 0; dvb < 2; ++dvb)
#pragma unroll
        for (int e = 0; e < 16; ++e) {
            float v = O[0][dvb][e] * inv[0];
            if constexpr (NC == 2) v -= lam * O[1][dvb][e] * inv[1];
            o[dvb][e] = v;
            ss += v * v;
        }
    float rstd = 1.f;
    if constexpr (NC == 2) {
        ss += __shfl_xor(ss, 32);
        rstd = rsqrtf(ss * (1.f / 64.f) + EPS) * post;
    }
    const int qrow = wave * 32 + r;
#pragma unroll
    for (int dvb = 0; dvb < 2; ++dvb)
#pragma unroll
        for (int g4 = 0; g4 < 4; ++g4) {
            int dv = dvb * 32 + 8 * g4 + 4 * hh;
            float4 gt = *(const float4*)(gate + (size_t)qrow * ZW + dv);
            float y0 = o[dvb][4 * g4 + 0] * rstd * siluf(gt.x), y1 = o[dvb][4 * g4 + 1] * rstd * siluf(gt.y);
            float y2 = o[dvb][4 * g4 + 2] * rstd * siluf(gt.z), y3 = o[dvb][4 * g4 + 3] * rstd * siluf(gt.w);
            if constexpr (NC == 2) {
                float4 ng = *(const float4*)(norm_g + dv);
                y0 *= ng.x; y1 *= ng.y; y2 *= ng.z; y3 *= ng.w;
            }
            *(uint2*)(outp + (size_t)qrow * 1024 + dv) = make_uint2(pack2(y0, y1), pack2(y2, y3));
        }
}

DEV void attn_item(const P& p, int l, int kind, int seq, int hd, int qb, char* smem) {
    const float* z = (const float*)(p.ws + WS_Z);
    const float* tab = (const float*)(p.ws + WS_ROPE);
    const float* lamp = (const float*)(p.ws + WS_LAM);
    bf16_t* mixed = (bf16_t*)(p.out + 4194304);
    const int tq0 = seq_tok0(seq) + qb * 128, kr0 = seq_kr0(seq), lk = seq_lk(seq);
    const bool rope = seq >= 16;
    const float LOG2E = 1.4426950408889634f;
    if (kind == 0) {
        attn_block<2, 2>(z + (size_t)tq0 * ZW + Z_DAQ + hd * 64, ZW, (const bf16_t*)(p.ws + WS_KD) + (size_t)kr0 * 256 + hd * 64, 256,
                         (const bf16_t*)(p.ws + WS_VDT) + seq_vt0(seq) + (size_t)hd * 64 * lk, lk, tab, rope, qb * 128,
                         0.17677669529663687f * LOG2E, lamp[l], 1.f - lamp[2 + l], p.da_norm + l * 64,
                         z + (size_t)tq0 * ZW + Z_DAG + hd * 64, mixed + (size_t)tq0 * 1024 + hd * 64, smem, nullptr);
    } else {
        attn_block<1, 6>((const float*)(p.ws + WS_QRAW) + (size_t)tq0 * 384 + hd * 96, 384, (const bf16_t*)(p.ws + WS_KMLA) + (size_t)kr0 * 384 + hd * 96, 384,
                         (const bf16_t*)(p.ws + WS_VMT) + seq_vt0(seq) + (size_t)hd * 64 * lk, lk, tab, rope, qb * 128,
                         0.10206207261596575f * LOG2E, 0.f, 1.f, nullptr,
                         z + (size_t)tq0 * ZW + Z_MLAG + hd * 64, mixed + (size_t)tq0 * 1024 + 768 + hd * 64, smem,
                         (const bf16_t*)(p.ws + WS_KROPE) + (size_t)kr0 * 32);
    }
}

#define XB_TMO      128
#define XB_XCNT(j)  (256  + 64 * (j))
#define XB_XSUB(j)  (1280 + 64 * (j))
#define XB_XGEN(j)  (2304 + 64 * (j))
#define XB_TOP      3328
#define XB_TOPGEN   3392
#define XCD_BAR_WORDS 3456
#define XB_SPIN_CAP (1u << 20)
#define LAS __attribute__((address_space(3)))
DEV unsigned xb_ld(unsigned* p) { return __hip_atomic_load(p, __ATOMIC_RELAXED, __HIP_MEMORY_SCOPE_AGENT); }
DEV unsigned xb_add(unsigned* p, unsigned v) { return __hip_atomic_fetch_add(p, v, __ATOMIC_RELAXED, __HIP_MEMORY_SCOPE_AGENT); }
DEV unsigned xb_xcc_id() { return (unsigned)__builtin_amdgcn_s_getreg((3 << 11) | 20) & 0xFu; }
#define XB_SPIN(cond, bar) do { unsigned _sp = 0; while (cond) { __builtin_amdgcn_s_sleep(1); \
    if ((++_sp & 255u) == 0u) { if (xb_ld(&(bar)[XB_TMO])) break; if (_sp > XB_SPIN_CAP) { atomicAdd(&(bar)[XB_TMO], 1u); break; } } } } while (0)
struct XcdBarrier { unsigned* bar; unsigned x; volatile LAS unsigned* st; };
DEV XcdBarrier xcd_barrier_post(unsigned* bar, volatile LAS unsigned* st) {
    XcdBarrier b; b.bar = bar; b.x = xb_xcc_id(); b.st = st;
    if (threadIdx.x == 0) (void)xb_add(&bar[XB_XCNT(b.x)], 1u);
    return b;
}
DEV void xcd_barrier_complete(unsigned* bar, unsigned x, unsigned& nloc, unsigned& nx) {
    const unsigned G = gridDim.x * gridDim.y * gridDim.z;
    unsigned sum, cnt, mine, sp = 0u;
    for (;;) {
        sum = 0u; cnt = 0u; mine = 0u;
#pragma unroll
        for (unsigned j = 0; j < 16; ++j) { const unsigned c = xb_ld(&bar[XB_XCNT(j)]); sum += c; cnt += (c > 0u) ? 1u : 0u; mine = (j == x) ? c : mine; }
        if (sum == G) break;
        __builtin_amdgcn_s_sleep(1);
        if ((++sp & 255u) == 0u) { if (xb_ld(&bar[XB_TMO])) break; if (sp > XB_SPIN_CAP) { atomicAdd(&bar[XB_TMO], 1u); break; } }
    }
    nloc = mine > 0u ? mine : 1u; nx = cnt > 0u ? cnt : 1u;
}
DEV void xcd_barrier(const XcdBarrier& b) {
    asm volatile("s_waitcnt vmcnt(0)" ::: "memory");
    __syncthreads();
    if (threadIdx.x == 0) {
        unsigned* bar = b.bar;
        __builtin_amdgcn_s_waitcnt(0);
        unsigned nloc = b.st[0], nx = b.st[1];
        if (nloc == 0u) { xcd_barrier_complete(bar, b.x, nloc, nx); b.st[0] = nloc; b.st[1] = nx; }
        const unsigned old = xb_add(&bar[XB_XSUB(b.x)], 1u);
        const unsigned gen = old / nloc;
        if (old + 1u == (gen + 1u) * nloc) {
            __builtin_amdgcn_fence(__ATOMIC_RELEASE, "agent");
            asm volatile("s_waitcnt vmcnt(0)" ::: "memory");
            const unsigned og = xb_add(&bar[XB_TOP], 1u);
            const unsigned tg = og / nx;
            if (og + 1u == (tg + 1u) * nx) xb_add(&bar[XB_TOPGEN], 1u);
            else XB_SPIN(xb_ld(&bar[XB_TOPGEN]) == tg, bar);
            __builtin_amdgcn_fence(__ATOMIC_ACQUIRE, "agent");
            xb_add(&bar[XB_XGEN(b.x)], 1u);
            asm volatile("s_waitcnt vmcnt(0)" ::: "memory");
        } else {
            XB_SPIN(xb_ld(&bar[XB_XGEN(b.x)]) == gen, bar);
            __builtin_amdgcn_fence(__ATOMIC_ACQUIRE, "agent");
            asm volatile("s_waitcnt vmcnt(0)" ::: "memory");
        }
    }
    __syncthreads();
}

DEV int sub_start(int bid, int off, int G) { int r = (bid - off) % G; return r < 0 ? r + G : r; }
__global__ void __launch_bounds__(256, 2) fwd_megakernel(P p) {
    extern __shared__ __attribute__((aligned(16))) char smem[];
    cg::grid_group grid = cg::this_grid();
    const int G = gridDim.x, bid = blockIdx.x;
    if (p.out == nullptr) grid.sync();
    volatile LAS unsigned* xst = (volatile LAS unsigned*)(smem + SMEM_WORK);
    if (threadIdx.x == 0) { xst[0] = 0u; xst[1] = 0u; xst[2] = 0u; xst[3] = 0u; }
    __syncthreads();
    const XcdBarrier xb = xcd_barrier_post((unsigned*)(p.ws + WS_BAR), xst);

    phase0(p, smem, 0);
    xcd_barrier(xb);
    phase0(p, smem, 1);
    for (int j = bid; j < ZW / 64; j += G) bias_block(p, j, smem);
    for (int e = bid * 256 + ltid(); e < 2 * 3 * 3072; e += G * 256) {
        const int j = e % 3072, lc = e / 3072;
        ((float*)(p.ws + WS_MODS))[e] = mod_val((const float*)(p.ws + WS_MODP), lc / 3, lc % 3, j);
    }
    phase_rownorm(p, 0, 0);
    xcd_barrier(xb);
    for (int rep = 0; rep < REP_SYNC; ++rep) xcd_barrier(xb);
#pragma nounroll
    for (int l = 0; l < 2; ++l) {
        for (int rep = 0; rep < REP_P1; ++rep) {
        {
            const bf16_t* A = (const bf16_t*)(p.ws + WS_H);
            const bf16_t* Bt = (const bf16_t*)(p.ws + WS_WIN) + (size_t)l * ZW * 1024;
            for (int t = bid; t < 64 * 27; t += G) gemm_tile<EPI_INPROJ>(p, l, A, 1024, Bt, 1024, 1024, (t & 63) * 128, (t >> 6) * 128, smem);
        }
        xcd_barrier(xb);
        }
        for (int rep = 0; rep < REP_X1; ++rep) {
        {
            constexpr int N_PREP = 408, N_HGA = 1024, N_S5A = 1024;
            for (int rr = 0; rr < REP_PREP; ++rr)
            for (int j = sub_start(bid, 0, G); j < N_PREP; j += G) prep_chunk(p, l, j, smem);
            for (int rr = 0; rr < REP_HGA; ++rr)
            for (int j = sub_start(bid, N_PREP, G); j < N_HGA; j += G) hga_block(p, l, j, smem);
            __syncthreads();
            for (int rr = 0; rr < REP_S5A; ++rr)
            for (int j = sub_start(bid, N_PREP + N_HGA, G); j < N_S5A; j += G) { const int wave = ltid() >> 6; s5a_wave(p, l, j * 4 + wave, smem + wave * 4096); }
        }
        xcd_barrier(xb);
        }
        for (int rep = 0; rep < REP_X2; ++rep) {
        {
            const bf16_t* cqn = (const bf16_t*)(p.ws + WS_CQN);
            const bf16_t* ckvn = (const bf16_t*)(p.ws + WS_CKVN);
            const bf16_t* WuqT = (const bf16_t*)(p.ws + WS_WUQ) + (size_t)l * 384 * 192;
            const bf16_t* WukvT = (const bf16_t*)(p.ws + WS_WUKV) + (size_t)l * 512 * 128;
            constexpr int N_UQ = 64 * 3, N_UKV = 68 * 4, N_HGC = 144 * 16;
            for (int j = sub_start(bid, 0, G); j < N_UQ; j += G) gemm_tile<EPI_UQ>(p, l, cqn, 192, WuqT, 192, 192, (j / 3) * 128, (j % 3) * 128, smem);
            for (int j = sub_start(bid, N_UQ, G); j < N_UKV; j += G) gemm_tile<EPI_UKV>(p, l, ckvn, 128, WukvT, 128, 128, (j >> 2) * 128, (j & 3) * 128, smem);
            for (int j = sub_start(bid, N_UQ + N_UKV, G); j < N_HGC; j += G) hgc_block(p, l, j);
        }
        xcd_barrier(xb);
        }
        for (int rep = 0; rep < REP_X3; ++rep) {
        {
            constexpr int N_AH = 256, N_HGB = 512, N_S5B = 512, N_AL = 256;
            for (int rr = 0; rr < REP_AH; ++rr)
            for (int j = sub_start(bid, 0, G); j < N_AH; j += G) {
                int kind = j & 1, hd = (j >> 1) & 3, sq = (j >> 3) & 1, qb = j >> 4;
                attn_item(p, l, kind, 16 + sq, hd, qb, smem);
            }
            for (int rr = 0; rr < REP_HGB; ++rr)
            for (int j = sub_start(bid, N_AH, G); j < N_HGB; j += G) hgb_block(p, l, j, smem);
            __syncthreads();
            for (int rr = 0; rr < REP_S5B; ++rr)
            for (int j = sub_start(bid, N_AH + N_HGB, G); j < N_S5B; j += G) { const int wave = ltid() >> 6; s5b_wave(p, l, j * 4 + wave, smem + wave * S5B_LDS); }
            for (int j = sub_start(bid, N_AH + N_HGB + N_S5B, G); j < N_AL; j += G) {
                int kind = j & 1, hd = (j >> 1) & 3, qb = (j >> 3) & 1, sq = j >> 4;
                attn_item(p, l, kind, sq, hd, qb, smem);
            }
        }
        xcd_barrier(xb);
        }
        for (int rep = 0; rep < REP_X4; ++rep) {
        {
            const bf16_t* gy = (const bf16_t*)(p.ws + WS_GY);
            const bf16_t* WgluT = (const bf16_t*)(p.ws + WS_WGLU) + (size_t)l * 512 * 256;
            for (int t = bid; t < 64 * 4; t += G) gemm_tile<EPI_GLU>(p, l, gy, 256, WgluT, 256, 256, (t & 63) * 128, (t >> 6) * 128, smem);
        }
        xcd_barrier(xb);
        }
        for (int rep = 0; rep < REP_P3; ++rep) {
        {
            const bf16_t* A = (const bf16_t*)(p.out + 4194304);
            const bf16_t* Bt = (const bf16_t*)(p.ws + WS_WOUT) + (size_t)l * 1024 * 1024;
            for (int t = bid; t < 64 * 8; t += G) gemm_tile<EPI_OUT>(p, l, A, 1024, Bt, 1024, 1024, (t & 63) * 128, (t >> 6) * 128, smem);
        }
        xcd_barrier(xb);
        }
    }
    phase_rownorm(p, 1, 1);
}

extern "C" void kernel_launch(void* const* d_in, const int* in_sizes, int n_in, void* d_out, int out_size, void* d_ws, size_t ws_size,
                              hipStream_t stream) {
    static int grid_blocks = 0;
    if (grid_blocks == 0) {
        int dev = 0, cus = 0, per_cu = 0;
        hipGetDevice(&dev);
        hipDeviceGetAttribute(&cus, hipDeviceAttributeMultiprocessorCount, dev);
        hipFuncSetAttribute((const void*)fwd_megakernel, hipFuncAttributeMaxDynamicSharedMemorySize, SMEM_BYTES);
        hipOccupancyMaxActiveBlocksPerMultiprocessor(&per_cu, (const void*)fwd_megakernel, 256, SMEM_BYTES);
        if (per_cu < 1) per_cu = 1;
        if (per_cu > 2) per_cu = 2;
        grid_blocks = cus * per_cu;
        if (ws_size < WS_END || n_in != 32) { fprintf(stderr, "kernel_launch: unexpected ws_size %zu / n_in %d\n", ws_size, n_in); }
    }
    if (hipMemsetAsync((char*)d_ws + WS_BAR, 0, 16384, stream) != hipSuccess) fprintf(stderr, "memset of barrier words failed\n");
    P p{};
    const float** f = (const float**)&p;
    for (int i = 0; i < 32; ++i) f[i] = (const float*)d_in[i];
    p.out = (float*)d_out;
    p.ws = (char*)d_ws;
    void* args[] = {&p};
    hipError_t e = hipLaunchCooperativeKernel((const void*)fwd_megakernel, dim3(grid_blocks), dim3(256), args, SMEM_BYTES, stream);
    if (e != hipSuccess) fprintf(stderr, "cooperative launch failed: %s (grid %d)\n", hipGetErrorString(e), grid_blocks);
}
```

```cpp
#include <hip/hip_runtime.h>
#include <hip/hip_cooperative_groups.h>
#include <stdint.h>
#include <stdio.h>
namespace cg = cooperative_groups;

typedef unsigned short bf16_t;
using bf16x8 = __attribute__((ext_vector_type(8))) short;
using f32x4 = __attribute__((ext_vector_type(4))) float;
using f32x16 = __attribute__((ext_vector_type(16))) float;
#define DEV __device__ __forceinline__

constexpr int NTOK = 8192, NCTX = 4096, ZW = 3456, INW = 3424, KROWS = 8704;
constexpr int Z_DAQ = 0, Z_DAK = 256, Z_DAV = 512, Z_DAG = 768, Z_S5U = 1024, Z_S5G = 1280, Z_HGQ = 1536, Z_HGFF = 1792,
              Z_HGFB = 2048, Z_HGI = 2304, Z_HGG = 2560, Z_CQ = 2816, Z_CKV = 3008, Z_KR = 3136, Z_MLAG = 3168;
constexpr size_t O_YP = 0, O_DK = 8388608, O_DV = 10485760, O_S5 = 12582912, O_HG = 12713984, O_CKV = 13762560, O_KR = 14811136;
constexpr float EPS = 1e-6f;

constexpr size_t al256(size_t x) { return (x + 255) & ~(size_t)255; }
constexpr size_t WS_WIN = 0;
constexpr size_t WS_WOUT = WS_WIN + (size_t)2 * ZW * 1024 * 2;
constexpr size_t WS_WGLU = WS_WOUT + (size_t)2 * 1024 * 1024 * 2;
constexpr size_t WS_WUQ = WS_WGLU + (size_t)2 * 512 * 256 * 2;
constexpr size_t WS_WUKV = WS_WUQ + (size_t)2 * 384 * 192 * 2;
constexpr size_t WS_MODP = WS_WUKV + (size_t)2 * 512 * 128 * 2;
constexpr size_t WS_ROPE = WS_MODP + (size_t)4 * 2 * 3 * 3072 * 4;
constexpr size_t WS_LAM = WS_ROPE + 4096;
constexpr size_t WS_H = WS_LAM + 256;
constexpr size_t WS_Z = WS_H + (size_t)NTOK * 1024 * 2;
constexpr size_t WS_KD = WS_Z + (size_t)NTOK * ZW * 4;
constexpr size_t WS_VDT = WS_KD + (size_t)KROWS * 256 * 2;
constexpr size_t VT_ELEMS = (size_t)16 * 4 * 64 * 256 + (size_t)2 * 4 * 64 * 2304;
constexpr size_t WS_KMLA = WS_VDT + VT_ELEMS * 2;
constexpr size_t WS_VMT = WS_KMLA + (size_t)KROWS * 384 * 2;
constexpr size_t WS_CQN = WS_VMT + VT_ELEMS * 2;
constexpr size_t WS_CKVN = WS_CQN + (size_t)NTOK * 192 * 2;
constexpr size_t WS_QRAW = WS_CKVN + (size_t)KROWS * 128 * 2;
constexpr size_t WS_S5F = WS_QRAW + (size_t)NTOK * 384 * 4;
constexpr size_t WS_HGS = WS_S5F + (size_t)128 * 2 * 16 * 64 * 2 * 4;
constexpr size_t WS_HGD = WS_HGS + (size_t)1024 * 4096 * 4;
constexpr size_t WS_GY = WS_HGD + (size_t)1024 * 64 * 4;
constexpr size_t WS_X1 = WS_GY + (size_t)NTOK * 256 * 2;
constexpr size_t WS_END = WS_X1 + (size_t)NTOK * 1024 * 4;
constexpr size_t WS_BAR = WS_END;
constexpr size_t WS_YP = WS_BAR + 16384;
constexpr size_t WS_KROPE = WS_YP + (size_t)NTOK * 256 * 4;
constexpr size_t WS_BIAS = WS_KROPE + (size_t)KROWS * 32 * 2;
constexpr size_t WS_SSQ = WS_BIAS + (size_t)3 * ZW * 4;
constexpr size_t WS_MODS = WS_SSQ + (size_t)16 * NTOK * 4;
constexpr size_t WS_TOTAL = WS_MODS + (size_t)2 * 3 * 3072 * 4;
static_assert(WS_TOTAL <= (size_t)256 * 1024 * 1024, "workspace too large");

#ifndef REP_AH
#define REP_AH 1
#endif
#ifndef REP_HGB
#define REP_HGB 1
#endif
#ifndef REP_S5B
#define REP_S5B 1
#endif
#ifndef REP_AL
#define REP_AL 1
#endif
#ifndef REP_PREP
#define REP_PREP 1
#endif
#ifndef REP_HGA
#define REP_HGA 1
#endif
#ifndef REP_S5A
#define REP_S5A 1
#endif
#ifndef REP_X2
#define REP_X2 1
#endif
#ifndef REP_P0
#define REP_P0 1
#endif
#ifndef REP_P1
#define REP_P1 1
#endif
#ifndef REP_X1
#define REP_X1 1
#endif
#ifndef REP_X3
#define REP_X3 1
#endif
#ifndef REP_X4
#define REP_X4 1
#endif
#ifndef REP_P3
#define REP_P3 1
#endif
#ifndef REP_SYNC
#define REP_SYNC 0
#endif
constexpr int SMEM_WORK = 2 * 2 * 128 * 72 * 2;
constexpr int SMEM_BYTES = SMEM_WORK + 16;

struct P {
    const float *x_prompt, *x_sample, *cdk, *cdv, *st_s5, *st_hg, *cckv, *ckrope, *c, *c_ctx, *w_mod, *b_mod, *w_in, *w_out,
        *da_lambda, *da_norm, *s5_a_re, *s5_a_im, *s5_log_dt, *s5_b_re, *s5_b_im, *s5_c_re, *s5_c_im, *s5_d, *s5_w_glu, *hg_lb,
        *hg_norm, *mla_q_norm, *mla_w_uq, *mla_kv_norm, *mla_w_ukv, *final_norm;
    float* out;
    char* ws;
};

DEV int ltid() { int t = threadIdx.x; asm volatile("" : "+v"(t)); return t; }
typedef __bf16 bf2_t __attribute__((ext_vector_type(2)));
typedef float f2_t __attribute__((ext_vector_type(2)));
DEV uint32_t pack2(float a, float b) {
    f2_t v = {a, b};
    bf2_t r = __builtin_convertvector(v, bf2_t);
    uint32_t u;
    __builtin_memcpy(&u, &r, 4);
    return u;
}
DEV bf16_t f2bf(float f) { return (bf16_t)(pack2(f, 0.f) & 0xffffu); }
DEV float siluf(float x) { return x / (1.f + __expf(-x)); }
DEV float sigmf(float x) { return 1.f / (1.f + __expf(-x)); }
DEV float geluf(float x) {
    float a = 0.7978845608028654f * (x + 0.044715f * x * x * x);
    float t = 1.f - 2.f / (__expf(2.f * a) + 1.f);
    return 0.5f * x * (1.f + t);
}
DEV float wave_sum(float v) {
#pragma unroll
    for (int o = 32; o >= 1; o >>= 1) v += __shfl_xor(v, o);
    return v;
}
DEV int tok_seq(int tok) { return tok < NCTX ? (tok >> 8) : 16 + ((tok - NCTX) >> 11); }
DEV int tok_cond(int tok) { return tok < NCTX ? 0 : 1 + ((tok - NCTX) >> 11); }
DEV int seq_tok0(int seq) { return seq < 16 ? seq * 256 : NCTX + (seq - 16) * 2048; }
DEV int seq_kr0(int seq) { return seq < 16 ? seq * 256 : NCTX + (seq - 16) * 2304; }
DEV int seq_lk(int seq) { return seq < 16 ? 256 : 2304; }
DEV size_t seq_vt0(int seq) { return seq < 16 ? (size_t)seq * 65536 : (size_t)1048576 + (size_t)(seq - 16) * 589824; }
DEV float mod_val(const float* modp, int l, int cond, int j) {
    float s = 0.f;
#pragma unroll
    for (int q = 0; q < 4; ++q) s += modp[((q * 2 + l) * 3 + cond) * 3072 + j];
    return s;
}

DEV void transpose_tile(const float* __restrict__ src, int K, int Nsrc, bf16_t* __restrict__ dst, int k0, int n0, int mode, float* tile) {
    int tid = ltid(), tx = tid & 63, ty = tid >> 6;
    int n = n0 + tx;
    int sc = (mode == 0) ? (n < Nsrc ? n : -1) : (((n >> 4) & 1) * 256 + (n >> 5) * 16 + (n & 15));
#pragma unroll 4
    for (int i = 0; i < 16; ++i) {
        int k = ty + 4 * i;
        tile[k * 65 + tx] = sc >= 0 ? src[(size_t)(k0 + k) * Nsrc + sc] : 0.f;
    }
    __syncthreads();
    int nl = tid >> 2, kq = tid & 3;
    uint32_t w[8];
#pragma unroll
    for (int j = 0; j < 8; ++j) w[j] = pack2(tile[(kq * 16 + 2 * j) * 65 + nl], tile[(kq * 16 + 2 * j + 1) * 65 + nl]);
    uint4* d = (uint4*)(dst + (size_t)(n0 + nl) * K + k0 + kq * 16);
    d[0] = make_uint4(w[0], w[1], w[2], w[3]);
    d[1] = make_uint4(w[4], w[5], w[6], w[7]);
    __syncthreads();
}

DEV void phase0(const P& p, char* smem, int part) {
    float* tile = (float*)smem;
    bf16_t* WinT = (bf16_t*)(p.ws + WS_WIN);
    bf16_t* WoutT = (bf16_t*)(p.ws + WS_WOUT);
    bf16_t* WgluT = (bf16_t*)(p.ws + WS_WGLU);
    bf16_t* WuqT = (bf16_t*)(p.ws + WS_WUQ);
    bf16_t* WukvT = (bf16_t*)(p.ws + WS_WUKV);
    float* modp = (float*)(p.ws + WS_MODP);
    constexpr int T_IN = 16 * 54, T_OUT = 16 * 16, T_GLU = 4 * 8, T_UQ = 3 * 6, T_UKV = 2 * 8;
    constexpr int T_L = T_IN + T_OUT + T_GLU + T_UQ + T_UKV;
    constexpr int N_MOD = 2 * 48 * 4;
    constexpr int TOTAL = N_MOD + 1 + 2 * T_L;
    const int it_lo = part == 0 ? 0 : N_MOD + 1, it_hi = part == 0 ? N_MOD + 1 : TOTAL;
    for (int it = it_lo + blockIdx.x; it < it_hi; it += gridDim.x) {
        if (it < N_MOD) {
            int l = it / 192, rem = it % 192, cb = rem >> 2, kq = rem & 3;
            int tid = ltid(), cl = tid & 63, kg = tid >> 6, col = cb * 64 + cl, kb = kq * 256 + kg * 64;
            float a0 = 0.f, a1 = 0.f, a2 = 0.f;
            const float* w = p.w_mod + ((size_t)l * 1024 + kb) * 3072 + col;
#pragma unroll 4
            for (int k = 0; k < 64; ++k) {
                float wv = w[(size_t)k * 3072];
                a0 += siluf(p.c_ctx[kb + k]) * wv;
                a1 += siluf(p.c[kb + k]) * wv;
                a2 += siluf(p.c[1024 + kb + k]) * wv;
            }
            tile[(0 * 4 + kg) * 64 + cl] = a0;
            tile[(1 * 4 + kg) * 64 + cl] = a1;
            tile[(2 * 4 + kg) * 64 + cl] = a2;
            __syncthreads();
            if (tid < 192) {
                int cond = tid >> 6;
                float s = tile[(cond * 4 + 0) * 64 + cl] + tile[(cond * 4 + 1) * 64 + cl] + tile[(cond * 4 + 2) * 64 + cl] + tile[(cond * 4 + 3) * 64 + cl];
                if (kq == 0) s += p.b_mod[l * 3072 + col];
                modp[((kq * 2 + l) * 3 + cond) * 3072 + col] = s;
            }
            __syncthreads();
        } else if (it == N_MOD) {
            float* tab = (float*)(p.ws + WS_ROPE);
            float* lam = (float*)(p.ws + WS_LAM);
            for (int e = ltid(); e < 512; e += 256) {
                int pos = e >> 3, f = e & 7;
                float inv = powf(10000.f, -(float)f / 8.f);
                float ang = (float)pos * inv;
                tab[e * 2] = cosf(ang);
                tab[e * 2 + 1] = sinf(ang);
            }
            if (ltid() < 2) {
                int l = ltid();
                const float* lv = p.da_lambda + l * 128;
                float s1 = 0.f, s2 = 0.f;
                for (int i = 0; i < 32; ++i) { s1 += lv[i] * lv[32 + i]; s2 += lv[64 + i] * lv[96 + i]; }
                float li = 0.8f - 0.6f * expf(-0.3f * (float)l);
                lam[l] = expf(s1) - expf(s2) + li;
                lam[2 + l] = li;
            }
        } else {
            int j = it - N_MOD - 1, l = j / T_L, r = j % T_L;
            if (r < T_IN) {
                transpose_tile(p.w_in + (size_t)l * 1024 * INW, 1024, INW, WinT + (size_t)l * ZW * 1024, (r / 54) * 64, (r % 54) * 64, 0, tile);
            } else if ((r -= T_IN) < T_OUT) {
                transpose_tile(p.w_out + (size_t)l * 1024 * 1024, 1024, 1024, WoutT + (size_t)l * 1024 * 1024, (r / 16) * 64, (r % 16) * 64, 0, tile);
            } else if ((r -= T_OUT) < T_GLU) {
                transpose_tile(p.s5_w_glu + (size_t)l * 256 * 512, 256, 512, WgluT + (size_t)l * 512 * 256, (r / 8) * 64, (r % 8) * 64, 1, tile);
            } else if ((r -= T_GLU) < T_UQ) {
                transpose_tile(p.mla_w_uq + (size_t)l * 192 * 384, 192, 384, WuqT + (size_t)l * 384 * 192, (r / 6) * 64, (r % 6) * 64, 0, tile);
            } else {
                r -= T_UQ;
                transpose_tile(p.mla_w_ukv + (size_t)l * 128 * 512, 128, 512, WukvT + (size_t)l * 512 * 128, (r / 8) * 64, (r % 8) * 64, 0, tile);
            }
        }
    }
}

DEV void bias_block(const P& p, int item, char* smem) {
    float* sh = (float*)smem;
    float* red = sh + 3 * 1024;
    const float* modp = (const float*)(p.ws + WS_MODP);
    const int tid = ltid(), cl = tid & 63, kg = tid >> 6, col = item * 64 + cl;
    __syncthreads();
    for (int idx = tid; idx < 3072; idx += 256) sh[idx] = mod_val(modp, 1, idx >> 10, idx & 1023);
    __syncthreads();
    float a0 = 0.f, a1 = 0.f, a2 = 0.f;
    if (col < INW) {
        const float* w = p.w_in + ((size_t)1024 + kg * 256) * INW + col;
#pragma unroll 8
        for (int k = 0; k < 256; ++k) {
            const float wv = w[(size_t)k * INW];
            a0 += sh[kg * 256 + k] * wv; a1 += sh[1024 + kg * 256 + k] * wv; a2 += sh[2048 + kg * 256 + k] * wv;
        }
    }
    red[(0 * 4 + kg) * 64 + cl] = a0; red[(1 * 4 + kg) * 64 + cl] = a1; red[(2 * 4 + kg) * 64 + cl] = a2;
    __syncthreads();
    if (tid < 192) {
        const int c = tid >> 6;
        ((float*)(p.ws + WS_BIAS))[c * ZW + item * 64 + cl] =
            red[(c * 4 + 0) * 64 + cl] + red[(c * 4 + 1) * 64 + cl] + red[(c * 4 + 2) * 64 + cl] + red[(c * 4 + 3) * 64 + cl];
    }
    __syncthreads();
}

DEV void phase_rownorm(const P& p, int l, int final_mode) {
    const float* modp = (const float*)(p.ws + WS_MODP);
    bf16_t* h = (bf16_t*)(p.ws + WS_H);
    int lane = ltid() & 63, wave = ltid() >> 6;
    for (int row = blockIdx.x * 4 + wave; row < NTOK; row += gridDim.x * 4) {
        const float* src;
        if (final_mode) src = row < NCTX ? (const float*)(p.ws + WS_H) + (size_t)row * 1024 : (const float*)(p.ws + WS_HGS) + (size_t)(row - NCTX) * 1024;
        else if (l == 0) src = row < NCTX ? p.x_prompt + (size_t)row * 1024 : p.x_sample + (size_t)(row - NCTX) * 1024;
        else src = (const float*)(p.ws + WS_X1) + (size_t)row * 1024;
        float4 v[4];
        float ss = 0.f;
#pragma unroll
        for (int i = 0; i < 4; ++i) {
            v[i] = ((const float4*)src)[lane + 64 * i];
            ss += v[i].x * v[i].x + v[i].y * v[i].y + v[i].z * v[i].z + v[i].w * v[i].w;
        }
        ss = wave_sum(ss);
        float rstd = rsqrtf(ss * (1.f / 1024.f) + EPS);
        if (final_mode) {
#pragma unroll
            for (int i = 0; i < 4; ++i) {
                int j = (lane + 64 * i) * 4;
                float4 g = *(const float4*)(p.final_norm + j);
                float4 o = make_float4(v[i].x * rstd * g.x, v[i].y * rstd * g.y, v[i].z * rstd * g.z, v[i].w * rstd * g.w);
                *(float4*)(p.out + O_YP + (size_t)row * 1024 + j) = o;
            }
        } else {
            int cond = tok_cond(row);
#pragma unroll
            for (int i = 0; i < 4; ++i) {
                int j = (lane + 64 * i) * 4;
                float sh[4], sc[4];
#pragma unroll
                for (int e = 0; e < 4; ++e) { sh[e] = mod_val(modp, l, cond, j + e); sc[e] = mod_val(modp, l, cond, 1024 + j + e); }
                float o0 = v[i].x * rstd * (1.f + sc[0]) + sh[0], o1 = v[i].y * rstd * (1.f + sc[1]) + sh[1];
                float o2 = v[i].z * rstd * (1.f + sc[2]) + sh[2], o3 = v[i].w * rstd * (1.f + sc[3]) + sh[3];
                *(uint2*)(h + (size_t)row * 1024 + j) = make_uint2(pack2(o0, o1), pack2(o2, o3));
            }
        }
    }
}

enum { EPI_INPROJ = 0, EPI_UQ = 1, EPI_UKV = 2, EPI_GLU = 3, EPI_OUT = 4 };

template <int EPI>
DEV void gemm_tile(const P& p, int l, const bf16_t* __restrict__ A, int lda, const bf16_t* __restrict__ Bt, int ldb, int K, int m0, int n0, char* smem) {
    char* As = smem;
    char* Bs = smem + 2 * 16384;
    const int tid = ltid(), lane = tid & 63, wave = tid >> 6, wr = wave >> 1, wc = wave & 1;
    f32x4 acc[4][4];
#pragma unroll
    for (int i = 0; i < 4; ++i)
#pragma unroll
        for (int j = 0; j < 4; ++j) acc[i][j] = f32x4{0.f, 0.f, 0.f, 0.f};
    const int srow = wave * 8 + (lane >> 3), schunk = (lane & 7) ^ ((lane >> 3) & 7);
    const bf16_t* Ag = A + (size_t)(m0 + srow) * lda + schunk * 8;
    const bf16_t* Bg = Bt + (size_t)(n0 + srow) * ldb + schunk * 8;
#define G_DMA(buf_, kt_)                                                                                                              \
    {                                                                                                                                 \
        _Pragma("unroll") for (int i = 0; i < 4; ++i) {                                                                               \
            __builtin_amdgcn_global_load_lds((const unsigned*)(Ag + (size_t)(32 * i) * lda + (kt_) * 64),                             \
                                             (unsigned*)(As + (buf_) * 16384 + wave * 1024 + i * 4096), 16, 0, 0);                    \
            __builtin_amdgcn_global_load_lds((const unsigned*)(Bg + (size_t)(32 * i) * ldb + (kt_) * 64),                             \
                                             (unsigned*)(Bs + (buf_) * 16384 + wave * 1024 + i * 4096), 16, 0, 0);                    \
        }                                                                                                                             \
    }
    const int fr = lane & 15, fq = lane >> 4;
    const int nk = K >> 6;
    G_DMA(0, 0)
    __syncthreads();
    for (int kt = 0; kt < nk; ++kt) {
        const int cur = kt & 1;
        if (kt + 1 < nk) G_DMA(cur ^ 1, kt + 1)
        const char* Ac = As + cur * 16384 + (wr * 64 + fr) * 128;
        const char* Bc = Bs + cur * 16384 + (wc * 64 + fr) * 128;
#pragma unroll
        for (int kk = 0; kk < 2; ++kk) {
            const int pc = ((kk * 4 + fq) ^ (fr & 7)) * 16;
            bf16x8 af[4], bfr[4];
#pragma unroll
            for (int i = 0; i < 4; ++i) {
                af[i] = *(const bf16x8*)(Ac + i * 16 * 128 + pc);
                bfr[i] = *(const bf16x8*)(Bc + i * 16 * 128 + pc);
            }
#pragma unroll
            for (int i = 0; i < 4; ++i)
#pragma unroll
                for (int j = 0; j < 4; ++j) acc[i][j] = __builtin_amdgcn_mfma_f32_16x16x32_bf16(bfr[j], af[i], acc[i][j], 0, 0, 0);
        }
        __syncthreads();
    }
#undef G_DMA
    const int rbase = m0 + wr * 64 + (lane & 15);
    const int cbase = n0 + wc * 64 + (lane >> 4) * 4;
    if constexpr (EPI == EPI_INPROJ) {
        float* z = (float*)(p.ws + WS_Z);
        const float* ssq = (const float*)(p.ws + WS_SSQ);
        const float* biasp = (const float*)(p.ws + WS_BIAS) + tok_cond(m0) * ZW;
#pragma unroll
        for (int mi = 0; mi < 4; ++mi) {
            const int row = rbase + mi * 16;
            const int b = row >> 8, t = row & 255;
            const size_t bt = (size_t)((b * 2 + l) * 256 + t);
            float rs = 1.f;
            if (l == 1) {
                float ssum = 0.f;
#pragma unroll
                for (int q = 0; q < 16; ++q) ssum += ssq[q * NTOK + row];
                rs = rsqrtf(ssum * (1.f / 1024.f) + EPS);
            }
#pragma unroll
            for (int ni = 0; ni < 4; ++ni) {
                const int col = cbase + ni * 16;
                float4 v = make_float4(acc[mi][ni][0], acc[mi][ni][1], acc[mi][ni][2], acc[mi][ni][3]);
                if (l == 1) {
                    const float4 bb = *(const float4*)(biasp + col);
                    v = make_float4(v.x * rs + bb.x, v.y * rs + bb.y, v.z * rs + bb.z, v.w * rs + bb.w);
                }
                *(float4*)(z + (size_t)row * ZW + col) = v;
                if (row < NCTX) {
                    if (col >= Z_DAK && col < Z_DAV) *(float4*)(p.out + O_DK + bt * 256 + (col - Z_DAK)) = v;
                    else if (col >= Z_DAV && col < Z_DAG) *(float4*)(p.out + O_DV + bt * 256 + (col - Z_DAV)) = v;
                    else if (col >= Z_KR && col < Z_MLAG) *(float4*)(p.out + O_KR + bt * 32 + (col - Z_KR)) = v;
                }
            }
        }
    } else if constexpr (EPI == EPI_UQ) {
        float* q = (float*)(p.ws + WS_QRAW);
#pragma unroll
        for (int mi = 0; mi < 4; ++mi)
#pragma unroll
            for (int ni = 0; ni < 4; ++ni)
                *(float4*)(q + (size_t)(rbase + mi * 16) * 384 + cbase + ni * 16) = make_float4(acc[mi][ni][0], acc[mi][ni][1], acc[mi][ni][2], acc[mi][ni][3]);
    } else if constexpr (EPI == EPI_UKV) {
        bf16_t* Kmla = (bf16_t*)(p.ws + WS_KMLA);
        bf16_t* VmT = (bf16_t*)(p.ws + WS_VMT);
        int seq = m0 < NCTX ? (m0 >> 8) : 16 + (m0 - NCTX) / 2304;
        int kr0 = seq_kr0(seq), lk = seq_lk(seq);
        size_t vt0 = seq_vt0(seq);
#pragma unroll
        for (int ni = 0; ni < 4; ++ni) {
            int col = cbase + ni * 16, hd = col >> 7, j = col & 127;
#pragma unroll
            for (int mi = 0; mi < 4; ++mi) {
                int row = rbase + mi * 16;
                if (j < 64) {
                    *(uint2*)(Kmla + (size_t)row * 384 + hd * 96 + j) = make_uint2(pack2(acc[mi][ni][0], acc[mi][ni][1]), pack2(acc[mi][ni][2], acc[mi][ni][3]));
                } else {
                    int key = row - kr0;
#pragma unroll
                    for (int r = 0; r < 4; ++r) VmT[vt0 + (size_t)(hd * 64 + (j - 64) + r) * lk + key] = f2bf(acc[mi][ni][r]);
                }
            }
        }
    } else if constexpr (EPI == EPI_GLU) {
        const float* z = (const float*)(p.ws + WS_Z);
        bf16_t* mixed = (bf16_t*)(p.out + 4194304);
#pragma unroll
        for (int np = 0; np < 2; ++np) {
            int colp = n0 + wc * 64 + np * 32;
            int j = (colp >> 5) * 16 + (lane >> 4) * 4;
#pragma unroll
            for (int mi = 0; mi < 4; ++mi) {
                int row = rbase + mi * 16;
                float4 gt = *(const float4*)(z + (size_t)row * ZW + Z_S5G + j);
                float y0 = acc[mi][2 * np][0] * sigmf(acc[mi][2 * np + 1][0]) * siluf(gt.x);
                float y1 = acc[mi][2 * np][1] * sigmf(acc[mi][2 * np + 1][1]) * siluf(gt.y);
                float y2 = acc[mi][2 * np][2] * sigmf(acc[mi][2 * np + 1][2]) * siluf(gt.z);
                float y3 = acc[mi][2 * np][3] * sigmf(acc[mi][2 * np + 1][3]) * siluf(gt.w);
                *(uint2*)(mixed + (size_t)row * 1024 + 256 + j) = make_uint2(pack2(y0, y1), pack2(y2, y3));
            }
        }
    } else if constexpr (EPI == EPI_OUT) {
        const float* mods = (const float*)(p.ws + WS_MODS);
        const float* x1 = (const float*)(p.ws + WS_X1);
        int cond = tok_cond(m0);
        float gate[4][4];
#pragma unroll
        for (int ni = 0; ni < 4; ++ni)
#pragma unroll
            for (int r = 0; r < 4; ++r) gate[ni][r] = mods[(l * 3 + cond) * 3072 + 2048 + cbase + ni * 16 + r];
        float sc1[4][4];
#pragma unroll
        for (int ni = 0; ni < 4; ++ni)
#pragma unroll
            for (int r = 0; r < 4; ++r) sc1[ni][r] = (l == 0) ? 1.f + mods[(3 + cond) * 3072 + 1024 + cbase + ni * 16 + r] : 1.f;
#pragma unroll
        for (int mi = 0; mi < 4; ++mi) {
            int row = rbase + mi * 16;
            const float* xp = (l == 0) ? (row < NCTX ? p.x_prompt + (size_t)row * 1024 : p.x_sample + (size_t)(row - NCTX) * 1024)
                                       : x1 + (size_t)row * 1024;
            float* xn = (l == 0) ? (float*)(p.ws + WS_X1) + (size_t)row * 1024
                                 : (row < NCTX ? (float*)(p.ws + WS_H) + (size_t)row * 1024 : (float*)(p.ws + WS_HGS) + (size_t)(row - NCTX) * 1024);
            float sq = 0.f;
#pragma unroll
            for (int ni = 0; ni < 4; ++ni) {
                int col = cbase + ni * 16;
                float4 xv = *(const float4*)(xp + col);
                const float4 xo = make_float4(xv.x + gate[ni][0] * acc[mi][ni][0], xv.y + gate[ni][1] * acc[mi][ni][1],
                                              xv.z + gate[ni][2] * acc[mi][ni][2], xv.w + gate[ni][3] * acc[mi][ni][3]);
                *(float4*)(xn + col) = xo;
                if (l == 0) {
                    sq += xo.x * xo.x + xo.y * xo.y + xo.z * xo.z + xo.w * xo.w;
                    *(uint2*)((bf16_t*)(p.ws + WS_H) + (size_t)row * 1024 + col) =
                        make_uint2(pack2(xo.x * sc1[ni][0], xo.y * sc1[ni][1]), pack2(xo.z * sc1[ni][2], xo.w * sc1[ni][3]));
                }
            }
            if (l == 0) {
                sq += __shfl_xor(sq, 16);
                sq += __shfl_xor(sq, 32);
                if ((lane >> 4) == 0) ((float*)(p.ws + WS_SSQ))[(size_t)((n0 >> 7) * 2 + wc) * NTOK + row] = sq;
            }
        }
    }
}

DEV void prep_chunk(const P& p, int l, int item, char* smem) {
    bf16_t* vbuf = (bf16_t*)smem;
    const float* z = (const float*)(p.ws + WS_Z);
    const float* tab = (const float*)(p.ws + WS_ROPE);
    bf16_t* Kd = (bf16_t*)(p.ws + WS_KD);
    bf16_t* VdT = (bf16_t*)(p.ws + WS_VDT);
    bf16_t* Kmla = (bf16_t*)(p.ws + WS_KMLA);
    bf16_t* cqn = (bf16_t*)(p.ws + WS_CQN);
    bf16_t* ckvn = (bf16_t*)(p.ws + WS_CKVN);
    const int part = item % 3;
    const int r0 = (item / 3) * 64;
    int seq, key0, tokb = 0, cb = 0, p0 = 0;
    bool cached = false, rope = false;
    if (r0 < NCTX) { seq = r0 >> 8; key0 = r0 & 255; tokb = r0; }
    else {
        int rr = r0 - NCTX; cb = rr / 2304; key0 = rr % 2304; seq = 16 + cb;
        if (key0 < 2048) { tokb = NCTX + cb * 2048 + key0; rope = true; }
        else { cached = true; p0 = key0 - 2048; }
    }
    const int lane = ltid() & 63, wave = ltid() >> 6;
#pragma unroll 4
    for (int i = wave; i < 64; i += 4) {
        const int kr = r0 + i;
        const float *dk, *dv, *krs, *ckv, *cq = nullptr;
        if (!cached) {
            const float* zr = z + (size_t)(tokb + i) * ZW;
            dk = zr + Z_DAK; dv = zr + Z_DAV; krs = zr + Z_KR; ckv = zr + Z_CKV; cq = zr + Z_CQ;
        } else {
            size_t bp = (size_t)((cb * 2 + l) * 256 + p0 + i);
            dk = p.cdk + bp * 256; dv = p.cdv + bp * 256; krs = p.ckrope + bp * 32; ckv = p.cckv + bp * 128;
        }
        const int t = key0 + i;
        if (part == 0) {
            float4 x = ((const float4*)dk)[lane];
            float xs[4] = {x.x, x.y, x.z, x.w};
            float px[4];
#pragma unroll
            for (int e = 0; e < 4; ++e) px[e] = __shfl_xor(xs[e], 2);
            if (rope) {
                int sect = (lane & 7) >> 2;
                int pos = sect ? (t & 63) : (t >> 6);
                bool lo = (lane & 3) < 2;
#pragma unroll
                for (int e = 0; e < 4; ++e) {
                    int f = 4 * (lane & 1) + e;
                    float cs = tab[(pos * 8 + f) * 2], sn = tab[(pos * 8 + f) * 2 + 1];
                    xs[e] = lo ? xs[e] * cs - px[e] * sn : px[e] * sn + xs[e] * cs;
                }
            }
            *(uint2*)(Kd + (size_t)kr * 256 + lane * 4) = make_uint2(pack2(xs[0], xs[1]), pack2(xs[2], xs[3]));
        }
        if (part == 1) {
            float4 x = ((const float4*)dv)[lane];
            *(uint2*)(vbuf + i * 260 + lane * 4) = make_uint2(pack2(x.x, x.y), pack2(x.z, x.w));
        }
        if (part == 2) {
            int l8 = lane & 7;
            float4 x = ((const float4*)krs)[l8];
            float xs[4] = {x.x, x.y, x.z, x.w};
            float px[4];
#pragma unroll
            for (int e = 0; e < 4; ++e) px[e] = __shfl_xor(xs[e], 2);
            if (rope) {
                int sect = l8 >> 2;
                int pos = sect ? (t & 63) : (t >> 6);
                bool lo = (l8 & 3) < 2;
#pragma unroll
                for (int e = 0; e < 4; ++e) {
                    int f = 4 * (l8 & 1) + e;
                    float cs = tab[(pos * 8 + f) * 2], sn = tab[(pos * 8 + f) * 2 + 1];
                    xs[e] = lo ? xs[e] * cs - px[e] * sn : px[e] * sn + xs[e] * cs;
                }
            }
            if (lane < 8) *(uint2*)((bf16_t*)(p.ws + WS_KROPE) + (size_t)kr * 32 + l8 * 4) = make_uint2(pack2(xs[0], xs[1]), pack2(xs[2], xs[3]));
        }
        if (part == 2) {
            float4 x = lane < 32 ? ((const float4*)ckv)[lane] : make_float4(0.f, 0.f, 0.f, 0.f);
            float o0 = x.x, o1 = x.y, o2 = x.z, o3 = x.w;
            if (!cached) {
                float ss = wave_sum(x.x * x.x + x.y * x.y + x.z * x.z + x.w * x.w);
                float rstd = rsqrtf(ss * (1.f / 128.f) + EPS);
                if (lane < 32) {
                    float4 g = ((const float4*)(p.mla_kv_norm + l * 128))[lane];
                    o0 = x.x * rstd * g.x; o1 = x.y * rstd * g.y; o2 = x.z * rstd * g.z; o3 = x.w * rstd * g.w;
                    if (r0 < NCTX) {
                        int b = kr >> 8, tt = kr & 255;
                        *(float4*)(p.out + O_CKV + (size_t)((b * 2 + l) * 256 + tt) * 128 + lane * 4) = make_float4(o0, o1, o2, o3);
                    }
                }
            }
            if (lane < 32) *(uint2*)(ckvn + (size_t)kr * 128 + lane * 4) = make_uint2(pack2(o0, o1), pack2(o2, o3));
        }
        if (part == 2 && !cached) {
            float4 x = lane < 48 ? ((const float4*)cq)[lane] : make_float4(0.f, 0.f, 0.f, 0.f);
            float ss = wave_sum(x.x * x.x + x.y * x.y + x.z * x.z + x.w * x.w);
            float rstd = rsqrtf(ss * (1.f / 192.f) + EPS);
            if (lane < 48) {
                float4 g = ((const float4*)(p.mla_q_norm + l * 192))[lane];
                *(uint2*)(cqn + (size_t)(tokb + i) * 192 + lane * 4) =
                    make_uint2(pack2(x.x * rstd * g.x, x.y * rstd * g.y), pack2(x.z * rstd * g.z, x.w * rstd * g.w));
            }
        }
    }
    if (part != 1) return;
    __syncthreads();
    {
        const int c = ltid(), lk = seq_lk(seq);
        bf16_t* dst = VdT + seq_vt0(seq) + (size_t)c * lk + key0;
#pragma unroll
        for (int q = 0; q < 8; ++q) {
            uint32_t w[4];
#pragma unroll
            for (int e = 0; e < 4; ++e) w[e] = (uint32_t)vbuf[(q * 8 + 2 * e) * 260 + c] | ((uint32_t)vbuf[(q * 8 + 2 * e + 1) * 260 + c] << 16);
            *(uint4*)(dst + q * 8) = make_uint4(w[0], w[1], w[2], w[3]);
        }
    }
    __syncthreads();
}

DEV void s5_params(const P& p, int l, int dir, int g, int lane, float& abr, float& abi, float (&bbr)[16], float (&bbi)[16]) {
    const int ldg = (l * 2 + dir) * 16 + g;
    float step = expf(p.s5_log_dt[ldg]);
    float are = p.s5_a_re[ldg * 64 + lane], aim = p.s5_a_im[ldg * 64 + lane];
    float mag = expf(are * step);
    float ang = aim * step;
    abr = mag * cosf(ang);
    abi = mag * sinf(ang);
    float den = are * are + aim * aim;
    float fre = ((abr - 1.f) * are + abi * aim) / den, fim = (abi * are - (abr - 1.f) * aim) / den;
    const float4* br = (const float4*)(p.s5_b_re + (size_t)(ldg * 64 + lane) * 16);
    const float4* bi = (const float4*)(p.s5_b_im + (size_t)(ldg * 64 + lane) * 16);
#pragma unroll
    for (int q = 0; q < 4; ++q) {
        float4 r = br[q], im = bi[q];
        bbr[4 * q + 0] = fre * r.x - fim * im.x; bbi[4 * q + 0] = fre * im.x + fim * r.x;
        bbr[4 * q + 1] = fre * r.y - fim * im.y; bbi[4 * q + 1] = fre * im.y + fim * r.y;
        bbr[4 * q + 2] = fre * r.z - fim * im.z; bbi[4 * q + 2] = fre * im.z + fim * r.z;
        bbr[4 * q + 3] = fre * r.w - fim * im.w; bbi[4 * q + 3] = fre * im.w + fim * r.w;
    }
}
DEV void s5_bu8(const float* ubuf, int sb, int dir, const float (&bbr)[16], const float (&bbi)[16], float (&bur)[8], float (&bui)[8]) {
#pragma unroll
    for (int ii = 0; ii < 8; ++ii) {
        const int i = dir ? 7 - ii : ii;
        const float4* up = (const float4*)(ubuf + (sb * 8 + i) * 16);
        float4 u0 = up[0], u1 = up[1], u2 = up[2], u3 = up[3];
        float r0 = bbr[0] * u0.x, r1 = bbr[1] * u0.y, i0 = bbi[0] * u0.x, i1 = bbi[1] * u0.y;
        r0 += bbr[2] * u0.z; r1 += bbr[3] * u0.w; i0 += bbi[2] * u0.z; i1 += bbi[3] * u0.w;
        r0 += bbr[4] * u1.x; r1 += bbr[5] * u1.y; i0 += bbi[4] * u1.x; i1 += bbi[5] * u1.y;
        r0 += bbr[6] * u1.z; r1 += bbr[7] * u1.w; i0 += bbi[6] * u1.z; i1 += bbi[7] * u1.w;
        r0 += bbr[8] * u2.x; r1 += bbr[9] * u2.y; i0 += bbi[8] * u2.x; i1 += bbi[9] * u2.y;
        r0 += bbr[10] * u2.z; r1 += bbr[11] * u2.w; i0 += bbi[10] * u2.z; i1 += bbi[11] * u2.w;
        r0 += bbr[12] * u3.x; r1 += bbr[13] * u3.y; i0 += bbi[12] * u3.x; i1 += bbi[13] * u3.y;
        r0 += bbr[14] * u3.z; r1 += bbr[15] * u3.w; i0 += bbi[14] * u3.z; i1 += bbi[15] * u3.w;
        bur[ii] = r0 + r1; bui[ii] = i0 + i1;
    }
}
DEV void s5_stage_u(const float* __restrict__ z, int tok0, int g, int lane, float* ubuf) {
    float4 v[4];
#pragma unroll
    for (int k = 0; k < 4; ++k) v[k] = *(const float4*)(z + (size_t)(tok0 + (lane >> 2) + 16 * k) * ZW + Z_S5U + g * 16 + (lane & 3) * 4);
#pragma unroll
    for (int k = 0; k < 4; ++k) *(float4*)(ubuf + ((lane >> 2) + 16 * k) * 16 + (lane & 3) * 4) = v[k];
    __builtin_amdgcn_wave_barrier();
    asm volatile("s_waitcnt lgkmcnt(0)" ::: "memory");
}
DEV void s5a_wave(const P& p, int l, int witem, char* smem_wave) {
    float* ubuf = (float*)smem_wave;
    const int lane = ltid() & 63;
    const int g = witem & 15, dir = (witem >> 4) & 1, gc = witem >> 5;
    float abr, abi, bbr[16], bbi[16];
    s5_params(p, l, dir, g, lane, abr, abi, bbr, bbi);
    const float* z = (const float*)(p.ws + WS_Z);
    const int tok0 = gc * 64;
    s5_stage_u(z, tok0, g, lane, ubuf);
    float hr = 0.f, hi = 0.f;
#pragma unroll 2
    for (int sbi = 0; sbi < 8; ++sbi) {
        const int sb = dir ? 7 - sbi : sbi;
        float bur[8], bui[8];
        s5_bu8(ubuf, sb, dir, bbr, bbi, bur, bui);
#pragma unroll
        for (int ii = 0; ii < 8; ++ii) {
            float nr = abr * hr - abi * hi + bur[ii], ni = abr * hi + abi * hr + bui[ii];
            hr = nr; hi = ni;
        }
    }
    float2* F = (float2*)(p.ws + WS_S5F);
    F[(size_t)((gc * 2 + dir) * 16 + g) * 64 + lane] = make_float2(hr, hi);
    __builtin_amdgcn_wave_barrier();
}
constexpr int S5H = 132;
constexpr int S5B_LDS = (64 * 16 + 16 * S5H) * 4;
DEV void s5_split8(const float4 a, const float4 b, bf16x8& hi, bf16x8& lo) {
    const float x[8] = {a.x, a.y, a.z, a.w, b.x, b.y, b.z, b.w};
    union { bf16x8 v; uint32_t u[4]; } H, L;
#pragma unroll
    for (int j = 0; j < 4; ++j) {
        const uint32_t h = pack2(x[2 * j], x[2 * j + 1]);
        const float h0 = __uint_as_float(h << 16), h1 = __uint_as_float(h & 0xffff0000u);
        H.u[j] = h;
        L.u[j] = pack2(x[2 * j] - h0, x[2 * j + 1] - h1);
    }
    hi = H.v; lo = L.v;
}
DEV void s5b_wave(const P& p, int l, int witem, char* smem_wave) {
    float* ubuf = (float*)smem_wave;
    float* hb = ubuf + 64 * 16;
    const int lane = ltid() & 63;
    const int g = witem & 15, gc = witem >> 4;
    const int tok0 = gc * 64;
    const int seq = tok_seq(tok0);
    const int nch = seq < 16 ? 4 : 32;
    const int gcb = seq < 16 ? seq * 4 : 64 + (seq - 16) * 32;
    const int cis = gc - gcb;
    const float* z = (const float*)(p.ws + WS_Z);
    const float2* F = (const float2*)(p.ws + WS_S5F);
    s5_stage_u(z, tok0, g, lane, ubuf);
    float* yp = (float*)(p.ws + WS_YP);
    bf16_t* gy = (bf16_t*)(p.ws + WS_GY);
    const int ch = lane & 15, kg = lane >> 4;
    const float dch = p.s5_d[l * 256 + g * 16 + ch];
#pragma nounroll
    for (int dir = 0; dir < 2; ++dir) {
        float abr, abi, bbr[16], bbi[16];
        s5_params(p, l, dir, g, lane, abr, abi, bbr, bbi);
        float pr = abr, pi = abi;
#pragma unroll
        for (int s = 0; s < 6; ++s) { float nr = pr * pr - pi * pi, ni = 2.f * pr * pi; pr = nr; pi = ni; }
        float hr = 0.f, hi = 0.f;
        if (seq >= 16) {
            const float* h0 = p.st_s5 + ((size_t)((((seq - 16) * 2 + l) * 2 + dir) * 16 + g) * 64 + lane) * 2;
            hr = h0[0]; hi = h0[1];
        }
        const int nprior = dir ? (nch - 1 - cis) : cis;
#pragma unroll 4
        for (int j = 0; j < nprior; ++j) {
            int c = dir ? (nch - 1 - j) : j;
            float2 f = F[(size_t)(((gcb + c) * 2 + dir) * 16 + g) * 64 + lane];
            float nr = pr * hr - pi * hi + f.x, ni = pr * hi + pi * hr + f.y;
            hr = nr; hi = ni;
        }
        bf16x8 chi[4], clo[4];
        {
            const float* cr = p.s5_c_re + (size_t)((l * 2 + dir) * 16 + g) * 16 * 64 + ch * 64;
            const float* ci = p.s5_c_im + (size_t)((l * 2 + dir) * 16 + g) * 16 * 64 + ch * 64;
#pragma unroll
            for (int s = 0; s < 4; ++s) {
                const float* src = (s < 2 ? cr : ci) + 32 * (s & 1) + 8 * kg;
                float4 a = *(const float4*)src, b = *(const float4*)(src + 4);
                if (s >= 2) { a.x = -a.x; a.y = -a.y; a.z = -a.z; a.w = -a.w; b.x = -b.x; b.y = -b.y; b.z = -b.z; b.w = -b.w; }
                s5_split8(a, b, chi[s], clo[s]);
            }
        }
#pragma nounroll
        for (int sbi = 0; sbi < 4; ++sbi) {
            const int sb = dir ? 3 - sbi : sbi;
#pragma nounroll
            for (int half = 0; half < 2; ++half) {
                const int h8 = dir ? 1 - half : half;
                float bur[8], bui[8];
                s5_bu8(ubuf, sb * 2 + h8, dir, bbr, bbi, bur, bui);
#pragma unroll
                for (int ii = 0; ii < 8; ++ii) {
                    const int i = h8 * 8 + (dir ? 7 - ii : ii);
                    float nr = abr * hr - abi * hi + bur[ii], ni = abr * hi + abi * hr + bui[ii];
                    hr = nr; hi = ni;
                    hb[i * S5H + lane] = hr;
                    hb[i * S5H + 64 + lane] = hi;
                }
            }
            __builtin_amdgcn_wave_barrier();
            asm volatile("s_waitcnt lgkmcnt(0)" ::: "memory");
            f32x4 acc = {0.f, 0.f, 0.f, 0.f};
#pragma unroll
            for (int s = 0; s < 4; ++s) {
                const float* hp = hb + (lane & 15) * S5H + 32 * s + 8 * kg;
                bf16x8 ahi, alo;
                s5_split8(*(const float4*)hp, *(const float4*)(hp + 4), ahi, alo);
                acc = __builtin_amdgcn_mfma_f32_16x16x32_bf16(ahi, chi[s], acc, 0, 0, 0);
                acc = __builtin_amdgcn_mfma_f32_16x16x32_bf16(ahi, clo[s], acc, 0, 0, 0);
                acc = __builtin_amdgcn_mfma_f32_16x16x32_bf16(alo, chi[s], acc, 0, 0, 0);
            }
#pragma unroll
            for (int r = 0; r < 4; ++r) {
                const int tl = sb * 16 + kg * 4 + r;
                float* ypp = yp + ((size_t)g * NTOK + tok0 + tl) * 16 + ch;
                if (dir == 0) {
                    *ypp = acc[r];
                } else {
                    const float y0 = __hip_atomic_load(ypp, __ATOMIC_RELAXED, __HIP_MEMORY_SCOPE_AGENT);
                    const float u = ubuf[tl * 16 + ch];
                    gy[(size_t)(tok0 + tl) * 256 + g * 16 + ch] = f2bf(geluf(y0 + acc[r] + dch * u));
                }
            }
            __builtin_amdgcn_wave_barrier();
            asm volatile("s_waitcnt lgkmcnt(0)" ::: "memory");
        }
        asm volatile("s_waitcnt vmcnt(0)" ::: "memory");
        if (seq < 16 && cis == (dir ? 0 : nch - 1)) {
            float* o = p.out + O_S5 + ((size_t)(((seq * 2 + l) * 2 + dir) * 16 + g) * 64 + lane) * 2;
            o[0] = hr; o[1] = hi;
        }
    }
    __builtin_amdgcn_wave_barrier();
    asm volatile("s_waitcnt lgkmcnt(0)" ::: "memory");
}

constexpr int HS = 68;
DEV void hg_load(const P& p, int l, int gc, int hd, int dir, float* qq, float* kk, float* bq, bool want_q) {
    const float* z = (const float*)(p.ws + WS_Z);
    const int tid = ltid(), d = tid & 63, rq = tid >> 6;
    float lb = 0.f;
    if (l > 0) {
        float e0 = expf(p.hg_lb[(0 * 2 + dir) * 256 + hd * 64 + d]), e1 = expf(p.hg_lb[(1 * 2 + dir) * 256 + hd * 64 + d]);
        lb = e1 / (e0 + e1);
    }
    const int zf = dir ? Z_HGFB : Z_HGFF;
    {
        float zz[16], qv[16];
#pragma unroll
        for (int k = 0; k < 16; ++k) {
            int i = rq + 4 * k;
            int tok = gc * 64 + (dir ? 63 - i : i);
            const float* zr = z + (size_t)tok * ZW;
            zz[k] = zr[zf + hd * 64 + d];
            qv[k] = want_q ? zr[Z_HGQ + hd * 64 + d] : 0.f;
        }
#pragma unroll
        for (int k = 0; k < 16; ++k) {
            int i = rq + 4 * k;
            float sg = sigmf(zz[k]);
            bq[d * HS + i] = __logf(lb + (1.f - lb) * sg);
            kk[d * HS + i] = (1.f - lb) * sigmf(-zz[k]);
            if (want_q) qq[d * HS + i] = qv[k];
        }
    }
    __syncthreads();
    float v[16];
    {
        const float4* src = (const float4*)(bq + d * HS + rq * 16);
        float4 a0 = src[0], a1 = src[1], a2 = src[2], a3 = src[3];
        float t[16] = {a0.x, a0.y, a0.z, a0.w, a1.x, a1.y, a1.z, a1.w, a2.x, a2.y, a2.z, a2.w, a3.x, a3.y, a3.z, a3.w};
        float run = 0.f;
#pragma unroll
        for (int k = 0; k < 16; ++k) { run += t[k]; v[k] = run; }
    }
    bq[d * HS + rq * 16 + 15] = v[15];
    __syncthreads();
    float off = 0.f;
#pragma unroll
    for (int q = 0; q < 3; ++q) off += (q < rq) ? bq[d * HS + q * 16 + 15] : 0.f;
    __syncthreads();
    {
        float4* dst = (float4*)(bq + d * HS + rq * 16);
        dst[0] = make_float4(v[0] + off, v[1] + off, v[2] + off, v[3] + off);
        dst[1] = make_float4(v[4] + off, v[5] + off, v[6] + off, v[7] + off);
        dst[2] = make_float4(v[8] + off, v[9] + off, v[10] + off, v[11] + off);
        dst[3] = make_float4(v[12] + off, v[13] + off, v[14] + off, v[15] + off);
    }
    __syncthreads();
}
DEV void hga_block(const P& p, int l, int item, char* smem) {
    float* kk = (float*)smem;
    float* bq = kk + 64 * HS;
    float* vv = bq + 64 * HS;
    const int dir = item & 1, hd = (item >> 1) & 3, gc = item >> 3;
    const float* z = (const float*)(p.ws + WS_Z);
    const int tid = ltid();
    __syncthreads();
    {
        const int vq = (tid & 15) * 4, i0 = tid >> 4;
#pragma unroll
        for (int k = 0; k < 4; ++k) {
            int i = i0 + 16 * k;
            int tok = gc * 64 + (dir ? 63 - i : i);
            *(float4*)(vv + i * 64 + vq) = *(const float4*)(z + (size_t)tok * ZW + Z_HGI + hd * 64 + vq);
        }
    }
    hg_load(p, l, gc, hd, dir, nullptr, kk, bq, false);
    {
        const int d = tid & 63, rq = tid >> 6;
        const float bl = bq[d * HS + 63];
        float4* kp = (float4*)(kk + d * HS + rq * 16);
        const float4* bp = (const float4*)(bq + d * HS + rq * 16);
#pragma unroll
        for (int k = 0; k < 4; ++k) {
            float4 kv = kp[k], bv = bp[k];
            kv.x *= __expf(bl - bv.x); kv.y *= __expf(bl - bv.y); kv.z *= __expf(bl - bv.z); kv.w *= __expf(bl - bv.w);
            kp[k] = kv;
        }
    }
    __syncthreads();
    float* S = (float*)(p.ws + WS_HGS) + (size_t)item * 4096;
    float* Dd = (float*)(p.ws + WS_HGD) + (size_t)item * 64;
    if (tid < 64) Dd[tid] = __expf(bq[tid * HS + 63]);
    const int db = (tid >> 4) * 4, vb = (tid & 15) * 4;
    float acc[4][4];
#pragma unroll
    for (int a = 0; a < 4; ++a)
#pragma unroll
        for (int b = 0; b < 4; ++b) acc[a][b] = 0.f;
#pragma unroll 2
    for (int i = 0; i < 64; i += 4) {
        float4 kd[4], v4[4];
#pragma unroll
        for (int a = 0; a < 4; ++a) kd[a] = *(const float4*)(kk + (db + a) * HS + i);
#pragma unroll
        for (int ii = 0; ii < 4; ++ii) v4[ii] = *(const float4*)(vv + (i + ii) * 64 + vb);
#pragma unroll
        for (int a = 0; a < 4; ++a) {
            const float ka[4] = {kd[a].x, kd[a].y, kd[a].z, kd[a].w};
#pragma unroll
            for (int ii = 0; ii < 4; ++ii) {
                acc[a][0] += ka[ii] * v4[ii].x; acc[a][1] += ka[ii] * v4[ii].y; acc[a][2] += ka[ii] * v4[ii].z; acc[a][3] += ka[ii] * v4[ii].w;
            }
        }
    }
#pragma unroll
    for (int a = 0; a < 4; ++a) *(float4*)(S + (db + a) * 64 + vb) = make_float4(acc[a][0], acc[a][1], acc[a][2], acc[a][3]);
    __syncthreads();
}
DEV void hgc_block(const P& p, int l, int item) {
    const int chain = item >> 4, sl = item & 15;
    const int dir = chain & 1, hd = (chain >> 1) & 3, seq = chain >> 3;
    const int e = sl * 256 + ltid();
    const int nch = seq < 16 ? 4 : 32, gcb = seq < 16 ? seq * 4 : 64 + (seq - 16) * 32;
    const float* Sb = (const float*)(p.ws + WS_HGS);
    float* Sn = p.out + O_YP;
    const float* Db = (const float*)(p.ws + WS_HGD);
    float S = 0.f;
    if (seq >= 16) S = p.st_hg[(size_t)((((seq - 16) * 2 + l) * 2 + dir) * 4 + hd) * 4096 + e];
    for (int c0 = 0; c0 < nch; c0 += 4) {
        float dS[4], Dv[4];
        size_t its[4];
#pragma unroll
        for (int k = 0; k < 4; ++k) {
            int c = dir ? nch - 1 - (c0 + k) : c0 + k;
            its[k] = (size_t)((gcb + c) * 4 + hd) * 2 + dir;
            dS[k] = Sb[its[k] * 4096 + e];
            Dv[k] = Db[its[k] * 64 + (e >> 6)];
        }
#pragma unroll
        for (int k = 0; k < 4; ++k) {
            Sn[its[k] * 4096 + e] = S;
            S = S * Dv[k] + dS[k];
        }
    }
    if (seq < 16) p.out[O_HG + (size_t)(((seq * 2 + l) * 2 + dir) * 4 + hd) * 4096 + e] = S;
}
DEV void hgb_block(const P& p, int l, int item, char* smem) {
    float* qq = (float*)smem;
    float* kk = qq + 64 * HS;
    float* bq = kk + 64 * HS;
    float* sc = bq + 64 * HS;
    const int hd = item & 3, gc = item >> 2;
    const float* z = (const float*)(p.ws + WS_Z);
    const int tid = ltid();
    __syncthreads();
    const int tb = (tid >> 4) * 4, vb = (tid & 15) * 4;
    float o[4][4];
#pragma unroll
    for (int a = 0; a < 4; ++a)
#pragma unroll
        for (int b = 0; b < 4; ++b) o[a][b] = 0.f;
#pragma nounroll
    for (int dir = 0; dir < 2; ++dir) {
        hg_load(p, l, gc, hd, dir, qq, kk, bq, true);
        const float* Sin = (const float*)(p.out + O_YP) + (size_t)((gc * 4 + hd) * 2 + dir) * 4096;
        const int pvq = (tid & 15) * 4, pr0 = tid >> 4;
#define HG_PF(k_, pvk_, psk_)                                                                     \
        {                                                                                             \
            const int i_ = pr0 + 16 * (k_);                                                           \
            const int tok_ = gc * 64 + (dir ? 63 - i_ : i_);                                          \
            pvk_ = *(const float4*)(z + (size_t)tok_ * ZW + Z_HGI + hd * 64 + pvq);                   \
            psk_ = *(const float4*)(Sin + i_ * 64 + pvq);                                             \
        }
        float4 pv0, pv1, pv2, pv3, ps0, ps1, ps2, ps3;
        HG_PF(0, pv0, ps0) HG_PF(1, pv1, ps1) HG_PF(2, pv2, ps2) HG_PF(3, pv3, ps3)
        {
            const int ib = (tid >> 4) * 4, sbk = (tid & 15) * 4;
            float a[4][4];
#pragma unroll
            for (int x = 0; x < 4; ++x)
#pragma unroll
                for (int y = 0; y < 4; ++y) a[x][y] = 0.f;
            if (sbk < ib) {
#pragma unroll 2
                for (int d = 0; d < 64; ++d) {
                    const float4 qi = *(const float4*)(qq + d * HS + ib), bi = *(const float4*)(bq + d * HS + ib);
                    const float4 ks = *(const float4*)(kk + d * HS + sbk), bs = *(const float4*)(bq + d * HS + sbk);
                    const float br = bi.x;
                    const float qe[4] = {qi.x, qi.y * __expf(bi.y - br), qi.z * __expf(bi.z - br), qi.w * __expf(bi.w - br)};
                    const float kf[4] = {ks.x * __expf(br - bs.x), ks.y * __expf(br - bs.y), ks.z * __expf(br - bs.z), ks.w * __expf(br - bs.w)};
#pragma unroll
                    for (int x = 0; x < 4; ++x)
#pragma unroll
                        for (int y = 0; y < 4; ++y) a[x][y] += qe[x] * kf[y];
                }
            } else if (sbk == ib) {
#pragma unroll 2
                for (int d = 0; d < 64; ++d) {
                    const float4 qi = *(const float4*)(qq + d * HS + ib), bi = *(const float4*)(bq + d * HS + ib);
                    const float4 ks = *(const float4*)(kk + d * HS + sbk);
                    const float qx[4] = {qi.x, qi.y, qi.z, qi.w}, bx[4] = {bi.x, bi.y, bi.z, bi.w}, ky[4] = {ks.x, ks.y, ks.z, ks.w};
#pragma unroll
                    for (int x = 0; x < 4; ++x)
#pragma unroll
                        for (int y = 0; y < 4; ++y)
                            if (y <= x) a[x][y] += qx[x] * ky[y] * __expf(bx[x] - bx[y]);
                }
            }
#pragma unroll
            for (int y = 0; y < 4; ++y) *(float4*)(sc + (sbk + y) * HS + ib) = make_float4(a[0][y], a[1][y], a[2][y], a[3][y]);
        }
        __syncthreads();
        float* vt_ = kk;
        float* st_ = bq;
        *(float4*)(vt_ + (pr0 + 0) * 64 + pvq) = pv0; *(float4*)(vt_ + (pr0 + 16) * 64 + pvq) = pv1;
        *(float4*)(vt_ + (pr0 + 32) * 64 + pvq) = pv2; *(float4*)(vt_ + (pr0 + 48) * 64 + pvq) = pv3;
        {
            const int d = tid & 63, rq = tid >> 6;
            float4* qp = (float4*)(qq + d * HS + rq * 16);
            const float4* bp = (const float4*)(bq + d * HS + rq * 16);
#pragma unroll
            for (int k = 0; k < 4; ++k) {
                float4 qv = qp[k], bv = bp[k];
                qv.x *= __expf(bv.x); qv.y *= __expf(bv.y); qv.z *= __expf(bv.z); qv.w *= __expf(bv.w);
                qp[k] = qv;
            }
        }
        __syncthreads();
        *(float4*)(st_ + (pr0 + 0) * 64 + pvq) = ps0; *(float4*)(st_ + (pr0 + 16) * 64 + pvq) = ps1;
        *(float4*)(st_ + (pr0 + 32) * 64 + pvq) = ps2; *(float4*)(st_ + (pr0 + 48) * 64 + pvq) = ps3;
        __syncthreads();
        const int i0 = dir ? 60 - tb : tb;
#pragma unroll 4
        for (int s = 0; s < 64; ++s) {
            const float4 v4 = *(const float4*)(vt_ + s * 64 + vb);
            const float4 s4 = *(const float4*)(st_ + s * 64 + vb);
            const float4 w4 = *(const float4*)(sc + s * HS + i0);
            const float4 q4 = *(const float4*)(qq + s * HS + i0);
            const float w[4] = {dir ? w4.w : w4.x, dir ? w4.z : w4.y, dir ? w4.y : w4.z, dir ? w4.x : w4.w};
            const float qe[4] = {dir ? q4.w : q4.x, dir ? q4.z : q4.y, dir ? q4.y : q4.z, dir ? q4.x : q4.w};
#pragma unroll
            for (int x = 0; x < 4; ++x) {
                o[x][0] += w[x] * v4.x + qe[x] * s4.x;
                o[x][1] += w[x] * v4.y + qe[x] * s4.y;
                o[x][2] += w[x] * v4.z + qe[x] * s4.z;
                o[x][3] += w[x] * v4.w + qe[x] * s4.w;
            }
        }
        __syncthreads();
    }
    bf16_t* mixed = (bf16_t*)(p.out + 4194304);
    const float4 g4 = *(const float4*)(p.hg_norm + l * 64 + vb);
#pragma unroll
    for (int x = 0; x < 4; ++x) {
        float ss = o[x][0] * o[x][0] + o[x][1] * o[x][1] + o[x][2] * o[x][2] + o[x][3] * o[x][3];
        ss += __shfl_xor(ss, 1); ss += __shfl_xor(ss, 2); ss += __shfl_xor(ss, 4); ss += __shfl_xor(ss, 8);
        float rstd = rsqrtf(ss * (1.f / 64.f) + EPS);
        int tok = gc * 64 + tb + x;
        float4 gt = *(const float4*)(z + (size_t)tok * ZW + Z_HGG + hd * 64 + vb);
        float y0 = o[x][0] * rstd * g4.x * siluf(gt.x), y1 = o[x][1] * rstd * g4.y * siluf(gt.y);
        float y2 = o[x][2] * rstd * g4.z * siluf(gt.z), y3 = o[x][3] * rstd * g4.w * siluf(gt.w);
        *(uint2*)(mixed + (size_t)tok * 1024 + 512 + hd * 64 + vb) = make_uint2(pack2(y0, y1), pack2(y2, y3));
    }
}

constexpr float ATT_THR = 5.0f;
template <int NC, int NDS>
DEV void attn_block(const float* __restrict__ qsrc, int qstride, const bf16_t* __restrict__ kbase, int kstride, const bf16_t* __restrict__ vt,
                    int Lk, const float* __restrict__ tab, bool rope, int t0, float qscale, float lam, float post,
                    const float* __restrict__ norm_g, const float* __restrict__ gate, bf16_t* __restrict__ outp, char* smem,
                    const bf16_t* __restrict__ krope) {
    constexpr int KW = NC * NDS * 16;
    constexpr int KP = KW + 8;
    constexpr int RC = KW / 8;
    constexpr int NKC = (64 * RC) / 256;
    constexpr int KS_STAGE = 64 * KP;
    constexpr int VS_STAGE = 64 * 72;
    bf16_t* Ks = (bf16_t*)smem;
    bf16_t* Vs = Ks + 2 * KS_STAGE;
    const int tid = ltid(), lane = tid & 63, wave = tid >> 6, r = lane & 31, hh = lane >> 5;
    __syncthreads();
    bf16x8 qf[NC][NDS];
    {
        const float* qs = qsrc + (size_t)(wave * 32 + r) * qstride;
#pragma unroll
        for (int c = 0; c < NC; ++c)
#pragma unroll
            for (int ds = 0; ds < NDS; ++ds) {
                const float* s = qs + (c * NDS + ds) * 16 + 8 * hh;
                float4 a = *(const float4*)s, b = *(const float4*)(s + 4);
                float x[8] = {a.x, a.y, a.z, a.w, b.x, b.y, b.z, b.w};
                if (ds >= NDS - 2) {
                    float px[8];
#pragma unroll
                    for (int j = 0; j < 8; ++j) px[j] = __shfl_xor(x[j], 32);
                    if (rope) {
                        int t = t0 + wave * 32 + r;
                        int pos = (ds == NDS - 2) ? (t >> 6) : (t & 63);
#pragma unroll
                        for (int j = 0; j < 8; ++j) {
                            float cs = tab[(pos * 8 + j) * 2], sn = tab[(pos * 8 + j) * 2 + 1];
                            x[j] = hh == 0 ? x[j] * cs - px[j] * sn : px[j] * sn + x[j] * cs;
                        }
                    }
                }
                union { bf16x8 v; uint32_t u[4]; } pk;
#pragma unroll
                for (int j = 0; j < 4; ++j) pk.u[j] = pack2(x[2 * j] * qscale, x[2 * j + 1] * qscale);
                qf[c][ds] = pk.v;
            }
    }
    f32x16 O[NC][2];
    float m[NC], ls[NC];
#pragma unroll
    for (int c = 0; c < NC; ++c) {
        m[c] = -1e30f; ls[c] = 0.f;
#pragma unroll
        for (int e = 0; e < 16; ++e) { O[c][0][e] = 0.f; O[c][1][e] = 0.f; }
    }
    uint4 rkA0, rkA1, rkA2, rvA0, rvA1, rkB0, rkB1, rkB2, rvB0, rvB1;
    const int vrow = tid >> 3, vcc = tid & 7;
#define ATT_GL1(dst_, i_, key0_)                                                                                                 \
    {                                                                                                                            \
        const int c = tid + 256 * (i_);                                                                                          \
        const int cc_ = c % RC, row_ = (key0_) + c / RC;                                                                         \
        dst_ = (RC <= 8 || cc_ < 8) ? *(const uint4*)(kbase + (size_t)row_ * kstride + cc_ * 8)                                  \
                                    : *(const uint4*)(krope + (size_t)row_ * 32 + (cc_ - 8) * 8);                                \
    }
#define ATT_GLOAD(S_, key0_)                                                                                                     \
    {                                                                                                                            \
        ATT_GL1(rk##S_##0, 0, key0_) ATT_GL1(rk##S_##1, 1, key0_)                                                                \
        if (NKC > 2) ATT_GL1(rk##S_##2, 2, key0_)                                                                                \
        rv##S_##0 = *(const uint4*)(vt + (size_t)vrow * Lk + (key0_) + vcc * 8);                                                 \
        rv##S_##1 = *(const uint4*)(vt + (size_t)(vrow + 32) * Lk + (key0_) + vcc * 8);                                          \
    }
#define ATT_SW1(src_, i_, buf_)                                                                                                  \
    {                                                                                                                            \
        const int c = tid + 256 * (i_);                                                                                          \
        *(uint4*)(Ks + (buf_) * KS_STAGE + (c / RC) * KP + (c % RC) * 8) = src_;                                                 \
    }
#define ATT_SWRITE(S_, buf_)                                                                                                     \
    {                                                                                                                            \
        ATT_SW1(rk##S_##0, 0, buf_) ATT_SW1(rk##S_##1, 1, buf_)                                                                  \
        if (NKC > 2) ATT_SW1(rk##S_##2, 2, buf_)                                                                                 \
        *(uint4*)(Vs + (buf_) * VS_STAGE + vrow * 72 + vcc * 8) = rv##S_##0;                                                     \
        *(uint4*)(Vs + (buf_) * VS_STAGE + (vrow + 32) * 72 + vcc * 8) = rv##S_##1;                                              \
    }
#define ATT_QK(step_, dst_)                                                                                          \
        {                                                                                                            \
            const int sub_ = (step_) / NC, c_ = (step_) % NC;                                                        \
            _Pragma("unroll") for (int e = 0; e < 16; ++e) dst_[e] = 0.f;                                            \
            _Pragma("unroll") for (int ds = 0; ds < NDS; ++ds) {                                                     \
                bf16x8 kf = *(const bf16x8*)(Kc + sub_ * 32 * KP + (c_ * NDS + ds) * 16);                            \
                dst_ = __builtin_amdgcn_mfma_f32_32x32x16_bf16(kf, qf[c_][ds], dst_, 0, 0, 0);                       \
            }                                                                                                        \
        }
#define ATT_COMPUTE(cur_)  { \
        const bf16_t* Kc = Ks + (cur_) * KS_STAGE + r * KP + 8 * hh; \
        const bf16_t* Vc = Vs + (cur_) * VS_STAGE + r * 72 + 4 * hh; \
        constexpr int NSTEP = 2 * NC; \
        f32x16 Sb[2]; \
        bf16x8 vf[2][2]; \
        ATT_QK(0, Sb[0]) \
        _Pragma("unroll") for (int step = 0; step < NSTEP; ++step) { \
        const int sub = step / NC, c = step % NC; \
        if (step + 1 < NSTEP) ATT_QK(step + 1, Sb[(step + 1) & 1]) \
        if (c == 0) { \
        _Pragma("unroll") for (int dvb = 0; dvb < 2; ++dvb) \
        _Pragma("unroll") for (int s = 0; s < 2; ++s) { \
        const bf16_t* vp = Vc + dvb * 32 * 72 + sub * 32 + 16 * s; \
        uint2 lo = *(const uint2*)vp, hi = *(const uint2*)(vp + 8); \
        union { bf16x8 v; uint32_t u[4]; } pk; \
        pk.u[0] = lo.x; pk.u[1] = lo.y; pk.u[2] = hi.x; pk.u[3] = hi.y; \
        vf[dvb][s] = pk.v; \
        } \
        } \
        f32x16 S = Sb[step & 1]; \
        float mx = S[0]; \
        _Pragma("unroll") for (int e = 1; e < 16; ++e) mx = fmaxf(mx, S[e]); \
        { \
        const auto sw = __builtin_amdgcn_permlane32_swap(__float_as_uint(mx), __float_as_uint(mx), false, false); \
        mx = fmaxf(__uint_as_float(sw[0]), __uint_as_float(sw[1])); \
        } \
        if (__builtin_amdgcn_ballot_w64(mx - m[c] > ATT_THR) != 0ull) { \
        const float mn = fmaxf(m[c], mx); \
        const float alpha = __builtin_amdgcn_exp2f(m[c] - mn); \
        m[c] = mn; \
        ls[c] *= alpha; \
        _Pragma("unroll") for (int e = 0; e < 16; ++e) { O[c][0][e] *= alpha; O[c][1][e] *= alpha; } \
        } \
        const float mcur = m[c]; \
        float rs = 0.f; \
        _Pragma("unroll") for (int e = 0; e < 16; ++e) { S[e] = __builtin_amdgcn_exp2f(S[e] - mcur); rs += S[e]; } \
        ls[c] += rs; \
        _Pragma("unroll") for (int s = 0; s < 2; ++s) { \
        union { bf16x8 v; uint32_t u[4]; } pk; \
        _Pragma("unroll") for (int j = 0; j < 4; ++j) pk.u[j] = pack2(S[8 * s + 2 * j], S[8 * s + 2 * j + 1]); \
        O[c][0] = __builtin_amdgcn_mfma_f32_32x32x16_bf16(vf[0][s], pk.v, O[c][0], 0, 0, 0); \
        O[c][1] = __builtin_amdgcn_mfma_f32_32x32x16_bf16(vf[1][s], pk.v, O[c][1], 0, 0, 0); \
        } \
        } \
    }
    constexpr int NSTEP = 2 * NC;
    const int nt = Lk >> 6;
    rkA2 = make_uint4(0u, 0u, 0u, 0u); rkB2 = rkA2;
    ATT_GLOAD(A, 0)
    ATT_SWRITE(A, 0)
    ATT_GLOAD(B, 64)
    __syncthreads();
    for (int kt = 0; kt < nt; kt += 2) {
        if (kt + 2 < nt) ATT_GLOAD(A, (kt + 2) * 64)
        ATT_COMPUTE(0)
        ATT_SWRITE(B, 1)
        __syncthreads();
        if (kt + 3 < nt) ATT_GLOAD(B, (kt + 3) * 64)
        ATT_COMPUTE(1)
        if (kt + 2 < nt) ATT_SWRITE(A, 0)
        __syncthreads();
    }
#undef ATT_QK
#undef ATT_COMPUTE
#undef ATT_GLOAD
#undef ATT_GL1
#undef ATT_SWRITE
#undef ATT_SW1
    float inv[NC];
#pragma unroll
    for (int c = 0; c < NC; ++c) { float lt = ls[c] + __shfl_xor(ls[c], 32); inv[c] = 1.f / lt; }
    float o[2][16];
    float ss = 0.f;
#pragma unroll
    for (int dvb = 0; dvb < 2; ++dvb)
#pragma unroll
        for (int e = 0; e < 16; ++e) {
            float v = O[0][dvb][e] * inv[0];
            if constexpr (NC == 2) v -= lam * O[1][dvb][e] * inv[1];
            o[dvb][e] = v;
            ss += v * v;
        }
    float rstd = 1.f;
    if constexpr (NC == 2) {
        ss += __shfl_xor(ss, 32);
        rstd = rsqrtf(ss * (1.f / 64.f) + EPS) * post;
    }
    const int qrow = wave * 32 + r;
#pragma unroll
    for (int dvb = 0; dvb < 2; ++dvb)
#pragma unroll
        for (int g4 = 0; g4 < 4; ++g4) {
            int dv = dvb * 32 + 8 * g4 + 4 * hh;
            float4 gt = *(const float4*)(gate + (size_t)qrow * ZW + dv);
            float y0 = o[dvb][4 * g4 + 0] * rstd * siluf(gt.x), y1 = o[dvb][4 * g4 + 1] * rstd * siluf(gt.y);
            float y2 = o[dvb][4 * g4 + 2] * rstd * siluf(gt.z), y3 = o[dvb][4 * g4 + 3] * rstd * siluf(gt.w);
            if constexpr (NC == 2) {
                float4 ng = *(const float4*)(norm_g + dv);
                y0 *= ng.x; y1 *= ng.y; y2 *= ng.z; y3 *= ng.w;
            }
            *(uint2*)(outp + (size_t)qrow * 1024 + dv) = make_uint2(pack2(y0, y1), pack2(y2, y3));
        }
}

DEV void attn_item(const P& p, int l, int kind, int seq, int hd, int qb, char* smem) {
    const float* z = (const float*)(p.ws + WS_Z);
    const float* tab = (const float*)(p.ws + WS_ROPE);
    const float* lamp = (const float*)(p.ws + WS_LAM);
    bf16_t* mixed = (bf16_t*)(p.out + 4194304);
    const int tq0 = seq_tok0(seq) + qb * 128, kr0 = seq_kr0(seq), lk = seq_lk(seq);
    const bool rope = seq >= 16;
    const float LOG2E = 1.4426950408889634f;
    if (kind == 0) {
        attn_block<2, 2>(z + (size_t)tq0 * ZW + Z_DAQ + hd * 64, ZW, (const bf16_t*)(p.ws + WS_KD) + (size_t)kr0 * 256 + hd * 64, 256,
                         (const bf16_t*)(p.ws + WS_VDT) + seq_vt0(seq) + (size_t)hd * 64 * lk, lk, tab, rope, qb * 128,
                         0.17677669529663687f * LOG2E, lamp[l], 1.f - lamp[2 + l], p.da_norm + l * 64,
                         z + (size_t)tq0 * ZW + Z_DAG + hd * 64, mixed + (size_t)tq0 * 1024 + hd * 64, smem, nullptr);
    } else {
        attn_block<1, 6>((const float*)(p.ws + WS_QRAW) + (size_t)tq0 * 384 + hd * 96, 384, (const bf16_t*)(p.ws + WS_KMLA) + (size_t)kr0 * 384 + hd * 96, 384,
                         (const bf16_t*)(p.ws + WS_VMT) + seq_vt0(seq) + (size_t)hd * 64 * lk, lk, tab, rope, qb * 128,
                         0.10206207261596575f * LOG2E, 0.f, 1.f, nullptr,
                         z + (size_t)tq0 * ZW + Z_MLAG + hd * 64, mixed + (size_t)tq0 * 1024 + 768 + hd * 64, smem,
                         (const bf16_t*)(p.ws + WS_KROPE) + (size_t)kr0 * 32);
    }
}

#define XB_TMO      128
#define XB_XCNT(j)  (256  + 64 * (j))
#define XB_XSUB(j)  (1280 + 64 * (j))
#define XB_XGEN(j)  (2304 + 64 * (j))
#define XB_TOP      3328
#define XB_TOPGEN   3392
#define XCD_BAR_WORDS 3456
#define XB_SPIN_CAP (1u << 20)
#define LAS __attribute__((address_space(3)))
DEV unsigned xb_ld(unsigned* p) { return __hip_atomic_load(p, __ATOMIC_RELAXED, __HIP_MEMORY_SCOPE_AGENT); }
DEV unsigned xb_add(unsigned* p, unsigned v) { return __hip_atomic_fetch_add(p, v, __ATOMIC_RELAXED, __HIP_MEMORY_SCOPE_AGENT); }
DEV unsigned xb_xcc_id() { return (unsigned)__builtin_amdgcn_s_getreg((3 << 11) | 20) & 0xFu; }
#define XB_SPIN(cond, bar) do { unsigned _sp = 0; while (cond) { __builtin_amdgcn_s_sleep(1); \
    if ((++_sp & 255u) == 0u) { if (xb_ld(&(bar)[XB_TMO])) break; if (_sp > XB_SPIN_CAP) { atomicAdd(&(bar)[XB_TMO], 1u); break; } } } } while (0)
struct XcdBarrier { unsigned* bar; unsigned x; volatile LAS unsigned* st; };
DEV XcdBarrier xcd_barrier_post(unsigned* bar, volatile LAS unsigned* st) {
    XcdBarrier b; b.bar = bar; b.x = xb_xcc_id(); b.st = st;
    if (threadIdx.x == 0) (void)xb_add(&bar[XB_XCNT(b.x)], 1u);
    return b;
}
DEV void xcd_barrier_complete(unsigned* bar, unsigned x, unsigned& nloc, unsigned& nx) {
    const unsigned G = gridDim.x * gridDim.y * gridDim.z;
    unsigned sum, cnt, mine, sp = 0u;
    for (;;) {
        sum = 0u; cnt = 0u; mine = 0u;
#pragma unroll
        for (unsigned j = 0; j < 16; ++j) { const unsigned c = xb_ld(&bar[XB_XCNT(j)]); sum += c; cnt += (c > 0u) ? 1u : 0u; mine = (j == x) ? c : mine; }
        if (sum == G) break;
        __builtin_amdgcn_s_sleep(1);
        if ((++sp & 255u) == 0u) { if (xb_ld(&bar[XB_TMO])) break; if (sp > XB_SPIN_CAP) { atomicAdd(&bar[XB_TMO], 1u); break; } }
    }
    nloc = mine > 0u ? mine : 1u; nx = cnt > 0u ? cnt : 1u;
}
DEV void xcd_barrier(const XcdBarrier& b) {
    asm volatile("s_waitcnt vmcnt(0)" ::: "memory");
    __syncthreads();
    if (threadIdx.x == 0) {
        unsigned* bar = b.bar;
        __builtin_amdgcn_s_waitcnt(0);
        unsigned nloc = b.st[0], nx = b.st[1];
        if (nloc == 0u) { xcd_barrier_complete(bar, b.x, nloc, nx); b.st[0] = nloc; b.st[1] = nx; }
        const unsigned old = xb_add(&bar[XB_XSUB(b.x)], 1u);
        const unsigned gen = old / nloc;
        if (old + 1u == (gen + 1u) * nloc) {
            __builtin_amdgcn_fence(__ATOMIC_RELEASE, "agent");
            asm volatile("s_waitcnt vmcnt(0)" ::: "memory");
            const unsigned og = xb_add(&bar[XB_TOP], 1u);
            const unsigned tg = og / nx;
            if (og + 1u == (tg + 1u) * nx) xb_add(&bar[XB_TOPGEN], 1u);
            else XB_SPIN(xb_ld(&bar[XB_TOPGEN]) == tg, bar);
            __builtin_amdgcn_fence(__ATOMIC_ACQUIRE, "agent");
            xb_add(&bar[XB_XGEN(b.x)], 1u);
            asm volatile("s_waitcnt vmcnt(0)" ::: "memory");
        } else {
            XB_SPIN(xb_ld(&bar[XB_XGEN(b.x)]) == gen, bar);
            __builtin_amdgcn_fence(__ATOMIC_ACQUIRE, "agent");
            asm volatile("s_waitcnt vmcnt(0)" ::: "memory");
        }
    }
    __syncthreads();
}

DEV int sub_start(int bid, int off, int G) { int r = (bid - off) % G; return r < 0 ? r + G : r; }
__global__ void __launch_bounds__(256, 2) fwd_megakernel(P p) {
    extern __shared__ __attribute__((aligned(16))) char smem[];
    cg::grid_group grid = cg::this_grid();
    const int G = gridDim.x, bid = blockIdx.x;
    if (p.out == nullptr) grid.sync();
    volatile LAS unsigned* xst = (volatile LAS unsigned*)(smem + SMEM_WORK);
    if (threadIdx.x == 0) { xst[0] = 0u; xst[1] = 0u; xst[2] = 0u; xst[3] = 0u; }
    __syncthreads();
    const XcdBarrier xb = xcd_barrier_post((unsigned*)(p.ws + WS_BAR), xst);

    phase0(p, smem, 0);
    xcd_barrier(xb);
    phase0(p, smem, 1);
    for (int j = bid; j < ZW / 64; j += G) bias_block(p, j, smem);
    for (int e = bid * 256 + ltid(); e < 2 * 3 * 3072; e += G * 256) {
        const int j = e % 3072, lc = e / 3072;
        ((float*)(p.ws + WS_MODS))[e] = mod_val((const float*)(p.ws + WS_MODP), lc / 3, lc % 3, j);
    }
    phase_rownorm(p, 0, 0);
    xcd_barrier(xb);
    for (int rep = 0; rep < REP_SYNC; ++rep) xcd_barrier(xb);
#pragma nounroll
    for (int l = 0; l < 2; ++l) {
        for (int rep = 0; rep < REP_P1; ++rep) {
        {
            const bf16_t* A = (const bf16_t*)(p.ws + WS_H);
            const bf16_t* Bt = (const bf16_t*)(p.ws + WS_WIN) + (size_t)l * ZW * 1024;
            for (int t = bid; t < 64 * 27; t += G) gemm_tile<EPI_INPROJ>(p, l, A, 1024, Bt, 1024, 1024, (t & 63) * 128, (t >> 6) * 128, smem);
        }
        xcd_barrier(xb);
        }
        for (int rep = 0; rep < REP_X1; ++rep) {
        {
            constexpr int N_PREP = 408, N_HGA = 1024, N_S5A = 1024;
            for (int rr = 0; rr < REP_PREP; ++rr)
            for (int j = sub_start(bid, 0, G); j < N_PREP; j += G) prep_chunk(p, l, j, smem);
            for (int rr = 0; rr < REP_HGA; ++rr)
            for (int j = sub_start(bid, N_PREP, G); j < N_HGA; j += G) hga_block(p, l, j, smem);
            __syncthreads();
            for (int rr = 0; rr < REP_S5A; ++rr)
            for (int j = sub_start(bid, N_PREP + N_HGA, G); j < N_S5A; j += G) { const int wave = ltid() >> 6; s5a_wave(p, l, j * 4 + wave, smem + wave * 4096); }
        }
        xcd_barrier(xb);
        }
        for (int rep = 0; rep < REP_X2; ++rep) {
        {
            const bf16_t* cqn = (const bf16_t*)(p.ws + WS_CQN);
            const bf16_t* ckvn = (const bf16_t*)(p.ws + WS_CKVN);
            const bf16_t* WuqT = (const bf16_t*)(p.ws + WS_WUQ) + (size_t)l * 384 * 192;
            const bf16_t* WukvT = (const bf16_t*)(p.ws + WS_WUKV) + (size_t)l * 512 * 128;
            constexpr int N_UQ = 64 * 3, N_UKV = 68 * 4, N_HGC = 144 * 16;
            for (int j = sub_start(bid, 0, G); j < N_UQ; j += G) gemm_tile<EPI_UQ>(p, l, cqn, 192, WuqT, 192, 192, (j / 3) * 128, (j % 3) * 128, smem);
            for (int j = sub_start(bid, N_UQ, G); j < N_UKV; j += G) gemm_tile<EPI_UKV>(p, l, ckvn, 128, WukvT, 128, 128, (j >> 2) * 128, (j & 3) * 128, smem);
            for (int j = sub_start(bid, N_UQ + N_UKV, G); j < N_HGC; j += G) hgc_block(p, l, j);
        }
        xcd_barrier(xb);
        }
        for (int rep = 0; rep < REP_X3; ++rep) {
        {
            constexpr int N_AH = 256, N_HGB = 512, N_S5B = 512, N_AL = 256;
            for (int rr = 0; rr < REP_AH; ++rr)
            for (int j = sub_start(bid, 0, G); j < N_AH; j += G) {
                int kind = j & 1, hd = (j >> 1) & 3, sq = (j >> 3) & 1, qb = j >> 4;
                attn_item(p, l, kind, 16 + sq, hd, qb, smem);
            }
            for (int rr = 0; rr < REP_HGB; ++rr)
            for (int j = sub_start(bid, N_AH, G); j < N_HGB; j += G) hgb_block(p, l, j, smem);
            __syncthreads();
            for (int rr = 0; rr < REP_S5B; ++rr)
            for (int j = sub_start(bid, N_AH + N_HGB, G); j < N_S5B; j += G) { const int wave = ltid() >> 6; s5b_wave(p, l, j * 4 + wave, smem + wave * S5B_LDS); }
            for (int j = sub_start(bid, N_AH + N_HGB + N_S5B, G); j < N_AL; j += G) {
                int kind = j & 1, hd = (j >> 1) & 3, qb = (j >> 3) & 1, sq = j >> 4;
                attn_item(p, l, kind, sq, hd, qb, smem);
            }
        }
        xcd_barrier(xb);
        }
        for (int rep = 0; rep < REP_X4; ++rep) {
        {
            const bf16_t* gy = (const bf16_t*)(p.ws + WS_GY);
            const bf16_t* WgluT = (const bf16_t*)(p.ws + WS_WGLU) + (size_t)l * 512 * 256;
            for (int t = bid; t < 64 * 4; t += G) gemm_tile<EPI_GLU>(p, l, gy, 256, WgluT, 256, 256, (t & 63) * 128, (t >> 6) * 128, smem);
        }
        xcd_barrier(xb);
        }
        for (int rep = 0; rep < REP_P3; ++rep) {
        {
            const bf16_t* A = (const bf16_t*)(p.out + 4194304);
            const bf16_t* Bt = (const bf16_t*)(p.ws + WS_WOUT) + (size_t)l * 1024 * 1024;
            for (int t = bid; t < 64 * 8; t += G) gemm_tile<EPI_OUT>(p, l, A, 1024, Bt, 1024, 1024, (t & 63) * 128, (t >> 6) * 128, smem);
        }
        xcd_barrier(xb);
        }
    }
    phase_rownorm(p, 1, 1);
}

extern "C" void kernel_launch(void* const* d_in, const int* in_sizes, int n_in, void* d_out, int out_size, void* d_ws, size_t ws_size,
                              hipStream_t stream) {
    static int grid_blocks = 0;
    if (grid_blocks == 0) {
        int dev = 0, cus = 0, per_cu = 0;
        hipGetDevice(&dev);
        hipDeviceGetAttribute(&cus, hipDeviceAttributeMultiprocessorCount, dev);
        hipFuncSetAttribute((const void*)fwd_megakernel, hipFuncAttributeMaxDynamicSharedMemorySize, SMEM_BYTES);
        hipOccupancyMaxActiveBlocksPerMultiprocessor(&per_cu, (const void*)fwd_megakernel, 256, SMEM_BYTES);
        if (per_cu < 1) per_cu = 1;
        if (per_cu > 2) per_cu = 2;
        grid_blocks = cus * per_cu;
        if (ws_size < WS_END || n_in != 32) { fprintf(stderr, "kernel_launch: unexpected ws_size %zu / n_in %d\n", ws_size, n_in); }
    }
    if (hipMemsetAsync((char*)d_ws + WS_BAR, 0, 16384, stream) != hipSuccess) fprintf(stderr, "memset of barrier words failed\n");
    P p{};
    const float** f = (const float**)&p;
    for (int i = 0; i < 32; ++i) f[i] = (const float*)d_in[i];
    p.out = (float*)d_out;
    p.ws = (char*)d_ws;
    void* args[] = {&p};
    hipError_t e = hipLaunchCooperativeKernel((const void*)fwd_megakernel, dim3(grid_blocks), dim3(256), args, SMEM_BYTES, stream);
    if (e != hipSuccess) fprintf(stderr, "cooperative launch failed: %s (grid %d)\n", hipGetErrorString(e), grid_blocks);
}
```

```cpp
#include <hip/hip_runtime.h>
#include <hip/hip_cooperative_groups.h>
#include <stdint.h>
#include <stdio.h>
namespace cg = cooperative_groups;

typedef unsigned short bf16_t;
using bf16x8 = __attribute__((ext_vector_type(8))) short;
using f32x4 = __attribute__((ext_vector_type(4))) float;
using f32x16 = __attribute__((ext_vector_type(16))) float;
#define DEV __device__ __forceinline__

constexpr int NTOK = 8192, NCTX = 4096, ZW = 3456, INW = 3424, KROWS = 8704;
constexpr int Z_DAQ = 0, Z_DAK = 256, Z_DAV = 512, Z_DAG = 768, Z_S5U = 1024, Z_S5G = 1280, Z_HGQ = 1536, Z_HGFF = 1792,
              Z_HGFB = 2048, Z_HGI = 2304, Z_HGG = 2560, Z_CQ = 2816, Z_CKV = 3008, Z_KR = 3136, Z_MLAG = 3168;
constexpr size_t O_YP = 0, O_DK = 8388608, O_DV = 10485760, O_S5 = 12582912, O_HG = 12713984, O_CKV = 13762560, O_KR = 14811136;
constexpr float EPS = 1e-6f;

constexpr size_t al256(size_t x) { return (x + 255) & ~(size_t)255; }
constexpr size_t WS_WIN = 0;
constexpr size_t WS_WOUT = WS_WIN + (size_t)2 * ZW * 1024 * 2;
constexpr size_t WS_WGLU = WS_WOUT + (size_t)2 * 1024 * 1024 * 2;
constexpr size_t WS_WUQ = WS_WGLU + (size_t)2 * 512 * 256 * 2;
constexpr size_t WS_WUKV = WS_WUQ + (size_t)2 * 384 * 192 * 2;
constexpr size_t WS_MODP = WS_WUKV + (size_t)2 * 512 * 128 * 2;
constexpr size_t WS_ROPE = WS_MODP + (size_t)4 * 2 * 3 * 3072 * 4;
constexpr size_t WS_LAM = WS_ROPE + 4096;
constexpr size_t WS_H = WS_LAM + 256;
constexpr size_t WS_Z = WS_H + (size_t)NTOK * 1024 * 2;
constexpr size_t WS_KD = WS_Z + (size_t)NTOK * ZW * 4;
constexpr size_t WS_VDT = WS_KD + (size_t)KROWS * 256 * 2;
constexpr size_t VT_ELEMS = (size_t)16 * 4 * 64 * 256 + (size_t)2 * 4 * 64 * 2304;
constexpr size_t WS_KMLA = WS_VDT + VT_ELEMS * 2;
constexpr size_t WS_VMT = WS_KMLA + (size_t)KROWS * 384 * 2;
constexpr size_t WS_CQN = WS_VMT + VT_ELEMS * 2;
constexpr size_t WS_CKVN = WS_CQN + (size_t)NTOK * 192 * 2;
constexpr size_t WS_QRAW = WS_CKVN + (size_t)KROWS * 128 * 2;
constexpr size_t WS_S5F = WS_QRAW + (size_t)NTOK * 384 * 4;
constexpr size_t WS_HGS = WS_S5F + (size_t)128 * 2 * 16 * 64 * 2 * 4;
constexpr size_t WS_HGD = WS_HGS + (size_t)1024 * 4096 * 4;
constexpr size_t WS_GY = WS_HGD + (size_t)1024 * 64 * 4;
constexpr size_t WS_X1 = WS_GY + (size_t)NTOK * 256 * 2;
constexpr size_t WS_END = WS_X1 + (size_t)NTOK * 1024 * 4;
constexpr size_t WS_BAR = WS_END;
constexpr size_t WS_YP = WS_BAR + 16384;
constexpr size_t WS_KROPE = WS_YP + (size_t)NTOK * 256 * 4;
constexpr size_t WS_BIAS = WS_KROPE + (size_t)KROWS * 32 * 2;
constexpr size_t WS_SSQ = WS_BIAS + (size_t)3 * ZW * 4;
constexpr size_t WS_MODS = WS_SSQ + (size_t)16 * NTOK * 4;
constexpr size_t WS_TOTAL = WS_MODS + (size_t)2 * 3 * 3072 * 4;
static_assert(WS_TOTAL <= (size_t)256 * 1024 * 1024, "workspace too large");

#ifndef REP_AH
#define REP_AH 1
#endif
#ifndef REP_HGB
#define REP_HGB 1
#endif
#ifndef REP_S5B
#define REP_S5B 1
#endif
#ifndef REP_AL
#define REP_AL 1
#endif
#ifndef REP_PREP
#define REP_PREP 1
#endif
#ifndef REP_HGA
#define REP_HGA 1
#endif
#ifndef REP_S5A
#define REP_S5A 1
#endif
#ifndef REP_X2
#define REP_X2 1
#endif
#ifndef REP_P0
#define REP_P0 1
#endif
#ifndef REP_P1
#define REP_P1 1
#endif
#ifndef REP_X1
#define REP_X1 1
#endif
#ifndef REP_X3
#define REP_X3 1
#endif
#ifndef REP_X4
#define REP_X4 1
#endif
#ifndef REP_P3
#define REP_P3 1
#endif
#ifndef REP_SYNC
#define REP_SYNC 0
#endif
constexpr int SMEM_WORK = 2 * 2 * 128 * 72 * 2;
constexpr int SMEM_BYTES = SMEM_WORK + 16;

struct P {
    const float *x_prompt, *x_sample, *cdk, *cdv, *st_s5, *st_hg, *cckv, *ckrope, *c, *c_ctx, *w_mod, *b_mod, *w_in, *w_out,
        *da_lambda, *da_norm, *s5_a_re, *s5_a_im, *s5_log_dt, *s5_b_re, *s5_b_im, *s5_c_re, *s5_c_im, *s5_d, *s5_w_glu, *hg_lb,
        *hg_norm, *mla_q_norm, *mla_w_uq, *mla_kv_norm, *mla_w_ukv, *final_norm;
    float* out;
    char* ws;
};

DEV int ltid() { int t = threadIdx.x; asm volatile("" : "+v"(t)); return t; }
typedef __bf16 bf2_t __attribute__((ext_vector_type(2)));
typedef float f2_t __attribute__((ext_vector_type(2)));
DEV uint32_t pack2(float a, float b) {
    f2_t v = {a, b};
    bf2_t r = __builtin_convertvector(v, bf2_t);
    uint32_t u;
    __builtin_memcpy(&u, &r, 4);
    return u;
}
DEV bf16_t f2bf(float f) { return (bf16_t)(pack2(f, 0.f) & 0xffffu); }
DEV float siluf(float x) { return x / (1.f + __expf(-x)); }
DEV float sigmf(float x) { return 1.f / (1.f + __expf(-x)); }
DEV float geluf(float x) {
    float a = 0.7978845608028654f * (x + 0.044715f * x * x * x);
    float t = 1.f - 2.f / (__expf(2.f * a) + 1.f);
    return 0.5f * x * (1.f + t);
}
DEV float wave_sum(float v) {
#pragma unroll
    for (int o = 32; o >= 1; o >>= 1) v += __shfl_xor(v, o);
    return v;
}
DEV int tok_seq(int tok) { return tok < NCTX ? (tok >> 8) : 16 + ((tok - NCTX) >> 11); }
DEV int tok_cond(int tok) { return tok < NCTX ? 0 : 1 + ((tok - NCTX) >> 11); }
DEV int seq_tok0(int seq) { return seq < 16 ? seq * 256 : NCTX + (seq - 16) * 2048; }
DEV int seq_kr0(int seq) { return seq < 16 ? seq * 256 : NCTX + (seq - 16) * 2304; }
DEV int seq_lk(int seq) { return seq < 16 ? 256 : 2304; }
DEV size_t seq_vt0(int seq) { return seq < 16 ? (size_t)seq * 65536 : (size_t)1048576 + (size_t)(seq - 16) * 589824; }
DEV float mod_val(const float* modp, int l, int cond, int j) {
    float s = 0.f;
#pragma unroll
    for (int q = 0; q < 4; ++q) s += modp[((q * 2 + l) * 3 + cond) * 3072 + j];
    return s;
}

DEV void transpose_tile(const float* __restrict__ src, int K, int Nsrc, bf16_t* __restrict__ dst, int k0, int n0, int mode, float* tile) {
    int tid = ltid(), tx = tid & 63, ty = tid >> 6;
    int n = n0 + tx;
    int sc = (mode == 0) ? (n < Nsrc ? n : -1) : (((n >> 4) & 1) * 256 + (n >> 5) * 16 + (n & 15));
#pragma unroll 4
    for (int i = 0; i < 16; ++i) {
        int k = ty + 4 * i;
        tile[k * 65 + tx] = sc >= 0 ? src[(size_t)(k0 + k) * Nsrc + sc] : 0.f;
    }
    __syncthreads();
    int nl = tid >> 2, kq = tid & 3;
    uint32_t w[8];
#pragma unroll
    for (int j = 0; j < 8; ++j) w[j] = pack2(tile[(kq * 16 + 2 * j) * 65 + nl], tile[(kq * 16 + 2 * j + 1) * 65 + nl]);
    uint4* d = (uint4*)(dst + (size_t)(n0 + nl) * K + k0 + kq * 16);
    d[0] = make_uint4(w[0], w[1], w[2], w[3]);
    d[1] = make_uint4(w[4], w[5], w[6], w[7]);
    __syncthreads();
}

DEV void phase0(const P& p, char* smem, int part) {
    float* tile = (float*)smem;
    bf16_t* WinT = (bf16_t*)(p.ws + WS_WIN);
    bf16_t* WoutT = (bf16_t*)(p.ws + WS_WOUT);
    bf16_t* WgluT = (bf16_t*)(p.ws + WS_WGLU);
    bf16_t* WuqT = (bf16_t*)(p.ws + WS_WUQ);
    bf16_t* WukvT = (bf16_t*)(p.ws + WS_WUKV);
    float* modp = (float*)(p.ws + WS_MODP);
    constexpr int T_IN = 16 * 54, T_OUT = 16 * 16, T_GLU = 4 * 8, T_UQ = 3 * 6, T_UKV = 2 * 8;
    constexpr int T_L = T_IN + T_OUT + T_GLU + T_UQ + T_UKV;
    constexpr int N_MOD = 2 * 48 * 4;
    constexpr int TOTAL = N_MOD + 1 + 2 * T_L;
    const int it_lo = part == 0 ? 0 : N_MOD + 1, it_hi = part == 0 ? N_MOD + 1 : TOTAL;
    for (int it = it_lo + blockIdx.x; it < it_hi; it += gridDim.x) {
        if (it < N_MOD) {
            int l = it / 192, rem = it % 192, cb = rem >> 2, kq = rem & 3;
            int tid = ltid(), cl = tid & 63, kg = tid >> 6, col = cb * 64 + cl, kb = kq * 256 + kg * 64;
            float a0 = 0.f, a1 = 0.f, a2 = 0.f;
            const float* w = p.w_mod + ((size_t)l * 1024 + kb) * 3072 + col;
#pragma unroll 4
            for (int k = 0; k < 64; ++k) {
                float wv = w[(size_t)k * 3072];
                a0 += siluf(p.c_ctx[kb + k]) * wv;
                a1 += siluf(p.c[kb + k]) * wv;
                a2 += siluf(p.c[1024 + kb + k]) * wv;
            }
            tile[(0 * 4 + kg) * 64 + cl] = a0;
            tile[(1 * 4 + kg) * 64 + cl] = a1;
            tile[(2 * 4 + kg) * 64 + cl] = a2;
            __syncthreads();
            if (tid < 192) {
                int cond = tid >> 6;
                float s = tile[(cond * 4 + 0) * 64 + cl] + tile[(cond * 4 + 1) * 64 + cl] + tile[(cond * 4 + 2) * 64 + cl] + tile[(cond * 4 + 3) * 64 + cl];
                if (kq == 0) s += p.b_mod[l * 3072 + col];
                modp[((kq * 2 + l) * 3 + cond) * 3072 + col] = s;
            }
            __syncthreads();
        } else if (it == N_MOD) {
            float* tab = (float*)(p.ws + WS_ROPE);
            float* lam = (float*)(p.ws + WS_LAM);
            for (int e = ltid(); e < 512; e += 256) {
                int pos = e >> 3, f = e & 7;
                float inv = powf(10000.f, -(float)f / 8.f);
                float ang = (float)pos * inv;
                tab[e * 2] = cosf(ang);
                tab[e * 2 + 1] = sinf(ang);
            }
            if (ltid() < 2) {
                int l = ltid();
                const float* lv = p.da_lambda + l * 128;
                float s1 = 0.f, s2 = 0.f;
                for (int i = 0; i < 32; ++i) { s1 += lv[i] * lv[32 + i]; s2 += lv[64 + i] * lv[96 + i]; }
                float li = 0.8f - 0.6f * expf(-0.3f * (float)l);
                lam[l] = expf(s1) - expf(s2) + li;
                lam[2 + l] = li;
            }
        } else {
            int j = it - N_MOD - 1, l = j / T_L, r = j % T_L;
            if (r < T_IN) {
                transpose_tile(p.w_in + (size_t)l * 1024 * INW, 1024, INW, WinT + (size_t)l * ZW * 1024, (r / 54) * 64, (r % 54) * 64, 0, tile);
            } else if ((r -= T_IN) < T_OUT) {
                transpose_tile(p.w_out + (size_t)l * 1024 * 1024, 1024, 1024, WoutT + (size_t)l * 1024 * 1024, (r / 16) * 64, (r % 16) * 64, 0, tile);
            } else if ((r -= T_OUT) < T_GLU) {
                transpose_tile(p.s5_w_glu + (size_t)l * 256 * 512, 256, 512, WgluT + (size_t)l * 512 * 256, (r / 8) * 64, (r % 8) * 64, 1, tile);
            } else if ((r -= T_GLU) < T_UQ) {
                transpose_tile(p.mla_w_uq + (size_t)l * 192 * 384, 192, 384, WuqT + (size_t)l * 384 * 192, (r / 6) * 64, (r % 6) * 64, 0, tile);
            } else {
                r -= T_UQ;
                transpose_tile(p.mla_w_ukv + (size_t)l * 128 * 512, 128, 512, WukvT + (size_t)l * 512 * 128, (r / 8) * 64, (r % 8) * 64, 0, tile);
            }
        }
    }
}

DEV void bias_block(const P& p, int item, char* smem) {
    float* sh = (float*)smem;
    float* red = sh + 3 * 1024;
    const float* modp = (const float*)(p.ws + WS_MODP);
    const int tid = ltid(), cl = tid & 63, kg = tid >> 6, col = item * 64 + cl;
    __syncthreads();
    for (int idx = tid; idx < 3072; idx += 256) sh[idx] = mod_val(modp, 1, idx >> 10, idx & 1023);
    __syncthreads();
    float a0 = 0.f, a1 = 0.f, a2 = 0.f;
    if (col < INW) {
        const float* w = p.w_in + ((size_t)1024 + kg * 256) * INW + col;
#pragma unroll 8
        for (int k = 0; k < 256; ++k) {
            const float wv = w[(size_t)k * INW];
            a0 += sh[kg * 256 + k] * wv; a1 += sh[1024 + kg * 256 + k] * wv; a2 += sh[2048 + kg * 256 + k] * wv;
        }
    }
    red[(0 * 4 + kg) * 64 + cl] = a0; red[(1 * 4 + kg) * 64 + cl] = a1; red[(2 * 4 + kg) * 64 + cl] = a2;
    __syncthreads();
    if (tid < 192) {
        const int c = tid >> 6;
        ((float*)(p.ws + WS_BIAS))[c * ZW + item * 64 + cl] =
            red[(c * 4 + 0) * 64 + cl] + red[(c * 4 + 1) * 64 + cl] + red[(c * 4 + 2) * 64 + cl] + red[(c * 4 + 3) * 64 + cl];
    }
    __syncthreads();
}

DEV void phase_rownorm(const P& p, int l, int final_mode) {
    const float* modp = (const float*)(p.ws + WS_MODP);
    bf16_t* h = (bf16_t*)(p.ws + WS_H);
    int lane = ltid() & 63, wave = ltid() >> 6;
    for (int row = blockIdx.x * 4 + wave; row < NTOK; row += gridDim.x * 4) {
        const float* src;
        if (final_mode) src = row < NCTX ? (const float*)(p.ws + WS_H) + (size_t)row * 1024 : (const float*)(p.ws + WS_HGS) + (size_t)(row - NCTX) * 1024;
        else if (l == 0) src = row < NCTX ? p.x_prompt + (size_t)row * 1024 : p.x_sample + (size_t)(row - NCTX) * 1024;
        else src = (const float*)(p.ws + WS_X1) + (size_t)row * 1024;
        float4 v[4];
        float ss = 0.f;
#pragma unroll
        for (int i = 0; i < 4; ++i) {
            v[i] = ((const float4*)src)[lane + 64 * i];
            ss += v[i].x * v[i].x + v[i].y * v[i].y + v[i].z * v[i].z + v[i].w * v[i].w;
        }
        ss = wave_sum(ss);
        float rstd = rsqrtf(ss * (1.f / 1024.f) + EPS);
        if (final_mode) {
#pragma unroll
            for (int i = 0; i < 4; ++i) {
                int j = (lane + 64 * i) * 4;
                float4 g = *(const float4*)(p.final_norm + j);
                float4 o = make_float4(v[i].x * rstd * g.x, v[i].y * rstd * g.y, v[i].z * rstd * g.z, v[i].w * rstd * g.w);
                *(float4*)(p.out + O_YP + (size_t)row * 1024 + j) = o;
            }
        } else {
            int cond = tok_cond(row);
#pragma unroll
            for (int i = 0; i < 4; ++i) {
                int j = (lane + 64 * i) * 4;
                float sh[4], sc[4];
#pragma unroll
                for (int e = 0; e < 4; ++e) { sh[e] = mod_val(modp, l, cond, j + e); sc[e] = mod_val(modp, l, cond, 1024 + j + e); }
                float o0 = v[i].x * rstd * (1.f + sc[0]) + sh[0], o1 = v[i].y * rstd * (1.f + sc[1]) + sh[1];
                float o2 = v[i].z * rstd * (1.f + sc[2]) + sh[2], o3 = v[i].w * rstd * (1.f + sc[3]) + sh[3];
                *(uint2*)(h + (size_t)row * 1024 + j) = make_uint2(pack2(o0, o1), pack2(o2, o3));
            }
        }
    }
}

enum { EPI_INPROJ = 0, EPI_UQ = 1, EPI_UKV = 2, EPI_GLU = 3, EPI_OUT = 4 };

template <int EPI>
DEV void gemm_tile(const P& p, int l, const bf16_t* __restrict__ A, int lda, const bf16_t* __restrict__ Bt, int ldb, int K, int m0, int n0, char* smem) {
    char* As = smem;
    char* Bs = smem + 2 * 16384;
    const int tid = ltid(), lane = tid & 63, wave = tid >> 6, wr = wave >> 1, wc = wave & 1;
    f32x4 acc[4][4];
#pragma unroll
    for (int i = 0; i < 4; ++i)
#pragma unroll
        for (int j = 0; j < 4; ++j) acc[i][j] = f32x4{0.f, 0.f, 0.f, 0.f};
    const int srow = wave * 8 + (lane >> 3), schunk = (lane & 7) ^ ((lane >> 3) & 7);
    const bf16_t* Ag = A + (size_t)(m0 + srow) * lda + schunk * 8;
    const bf16_t* Bg = Bt + (size_t)(n0 + srow) * ldb + schunk * 8;
#define G_DMA(buf_, kt_)                                                                                                              \
    {                                                                                                                                 \
        _Pragma("unroll") for (int i = 0; i < 4; ++i) {                                                                               \
            __builtin_amdgcn_global_load_lds((const unsigned*)(Ag + (size_t)(32 * i) * lda + (kt_) * 64),                             \
                                             (unsigned*)(As + (buf_) * 16384 + wave * 1024 + i * 4096), 16, 0, 0);                    \
            __builtin_amdgcn_global_load_lds((const unsigned*)(Bg + (size_t)(32 * i) * ldb + (kt_) * 64),                             \
                                             (unsigned*)(Bs + (buf_) * 16384 + wave * 1024 + i * 4096), 16, 0, 0);                    \
        }                                                                                                                             \
    }
    const int fr = lane & 15, fq = lane >> 4;
    const int nk = K >> 6;
    G_DMA(0, 0)
    __syncthreads();
    for (int kt = 0; kt < nk; ++kt) {
        const int cur = kt & 1;
        if (kt + 1 < nk) G_DMA(cur ^ 1, kt + 1)
        const char* Ac = As + cur * 16384 + (wr * 64 + fr) * 128;
        const char* Bc = Bs + cur * 16384 + (wc * 64 + fr) * 128;
#pragma unroll
        for (int kk = 0; kk < 2; ++kk) {
            const int pc = ((kk * 4 + fq) ^ (fr & 7)) * 16;
            bf16x8 af[4], bfr[4];
#pragma unroll
            for (int i = 0; i < 4; ++i) {
                af[i] = *(const bf16x8*)(Ac + i * 16 * 128 + pc);
                bfr[i] = *(const bf16x8*)(Bc + i * 16 * 128 + pc);
            }
#pragma unroll
            for (int i = 0; i < 4; ++i)
#pragma unroll
                for (int j = 0; j < 4; ++j) acc[i][j] = __builtin_amdgcn_mfma_f32_16x16x32_bf16(bfr[j], af[i], acc[i][j], 0, 0, 0);
        }
        __syncthreads();
    }
#undef G_DMA
    const int rbase = m0 + wr * 64 + (lane & 15);
    const int cbase = n0 + wc * 64 + (lane >> 4) * 4;
    if constexpr (EPI == EPI_INPROJ) {
        float* z = (float*)(p.ws + WS_Z);
        const float* ssq = (const float*)(p.ws + WS_SSQ);
        const float* biasp = (const float*)(p.ws + WS_BIAS) + tok_cond(m0) * ZW;
#pragma unroll
        for (int mi = 0; mi < 4; ++mi) {
            const int row = rbase + mi * 16;
            const int b = row >> 8, t = row & 255;
            const size_t bt = (size_t)((b * 2 + l) * 256 + t);
            float rs = 1.f;
            if (l == 1) {
                float ssum = 0.f;
#pragma unroll
                for (int q = 0; q < 16; ++q) ssum += ssq[q * NTOK + row];
                rs = rsqrtf(ssum * (1.f / 1024.f) + EPS);
            }
#pragma unroll
            for (int ni = 0; ni < 4; ++ni) {
                const int col = cbase + ni * 16;
                float4 v = make_float4(acc[mi][ni][0], acc[mi][ni][1], acc[mi][ni][2], acc[mi][ni][3]);
                if (l == 1) {
                    const float4 bb = *(const float4*)(biasp + col);
                    v = make_float4(v.x * rs + bb.x, v.y * rs + bb.y, v.z * rs + bb.z, v.w * rs + bb.w);
                }
                *(float4*)(z + (size_t)row * ZW + col) = v;
                if (row < NCTX) {
                    if (col >= Z_DAK && col < Z_DAV) *(float4*)(p.out + O_DK + bt * 256 + (col - Z_DAK)) = v;
                    else if (col >= Z_DAV && col < Z_DAG) *(float4*)(p.out + O_DV + bt * 256 + (col - Z_DAV)) = v;
                    else if (col >= Z_KR && col < Z_MLAG) *(float4*)(p.out + O_KR + bt * 32 + (col - Z_KR)) = v;
                }
            }
        }
    } else if constexpr (EPI == EPI_UQ) {
        float* q = (float*)(p.ws + WS_QRAW);
#pragma unroll
        for (int mi = 0; mi < 4; ++mi)
#pragma unroll
            for (int ni = 0; ni < 4; ++ni)
                *(float4*)(q + (size_t)(rbase + mi * 16) * 384 + cbase + ni * 16) = make_float4(acc[mi][ni][0], acc[mi][ni][1], acc[mi][ni][2], acc[mi][ni][3]);
    } else if constexpr (EPI == EPI_UKV) {
        bf16_t* Kmla = (bf16_t*)(p.ws + WS_KMLA);
        bf16_t* VmT = (bf16_t*)(p.ws + WS_VMT);
        int seq = m0 < NCTX ? (m0 >> 8) : 16 + (m0 - NCTX) / 2304;
        int kr0 = seq_kr0(seq), lk = seq_lk(seq);
        size_t vt0 = seq_vt0(seq);
#pragma unroll
        for (int ni = 0; ni < 4; ++ni) {
            int col = cbase + ni * 16, hd = col >> 7, j = col & 127;
#pragma unroll
            for (int mi = 0; mi < 4; ++mi) {
                int row = rbase + mi * 16;
                if (j < 64) {
                    *(uint2*)(Kmla + (size_t)row * 384 + hd * 96 + j) = make_uint2(pack2(acc[mi][ni][0], acc[mi][ni][1]), pack2(acc[mi][ni][2], acc[mi][ni][3]));
                } else {
                    int key = row - kr0;
#pragma unroll
                    for (int r = 0; r < 4; ++r) VmT[vt0 + (size_t)(hd * 64 + (j - 64) + r) * lk + key] = f2bf(acc[mi][ni][r]);
                }
            }
        }
    } else if constexpr (EPI == EPI_GLU) {
        const float* z = (const float*)(p.ws + WS_Z);
        bf16_t* mixed = (bf16_t*)(p.out + 4194304);
#pragma unroll
        for (int np = 0; np < 2; ++np) {
            int colp = n0 + wc * 64 + np * 32;
            int j = (colp >> 5) * 16 + (lane >> 4) * 4;
#pragma unroll
            for (int mi = 0; mi < 4; ++mi) {
                int row = rbase + mi * 16;
                float4 gt = *(const float4*)(z + (size_t)row * ZW + Z_S5G + j);
                float y0 = acc[mi][2 * np][0] * sigmf(acc[mi][2 * np + 1][0]) * siluf(gt.x);
                float y1 = acc[mi][2 * np][1] * sigmf(acc[mi][2 * np + 1][1]) * siluf(gt.y);
                float y2 = acc[mi][2 * np][2] * sigmf(acc[mi][2 * np + 1][2]) * siluf(gt.z);
                float y3 = acc[mi][2 * np][3] * sigmf(acc[mi][2 * np + 1][3]) * siluf(gt.w);
                *(uint2*)(mixed + (size_t)row * 1024 + 256 + j) = make_uint2(pack2(y0, y1), pack2(y2, y3));
            }
        }
    } else if constexpr (EPI == EPI_OUT) {
        const float* mods = (const float*)(p.ws + WS_MODS);
        const float* x1 = (const float*)(p.ws + WS_X1);
        int cond = tok_cond(m0);
        float gate[4][4];
#pragma unroll
        for (int ni = 0; ni < 4; ++ni)
#pragma unroll
            for (int r = 0; r < 4; ++r) gate[ni][r] = mods[(l * 3 + cond) * 3072 + 2048 + cbase + ni * 16 + r];
        float sc1[4][4];
#pragma unroll
        for (int ni = 0; ni < 4; ++ni)
#pragma unroll
            for (int r = 0; r < 4; ++r) sc1[ni][r] = (l == 0) ? 1.f + mods[(3 + cond) * 3072 + 1024 + cbase + ni * 16 + r] : 1.f;
#pragma unroll
        for (int mi = 0; mi < 4; ++mi) {
            int row = rbase + mi * 16;
            const float* xp = (l == 0) ? (row < NCTX ? p.x_prompt + (size_t)row * 1024 : p.x_sample + (size_t)(row - NCTX) * 1024)
                                       : x1 + (size_t)row * 1024;
            float* xn = (l == 0) ? (float*)(p.ws + WS_X1) + (size_t)row * 1024
                                 : (row < NCTX ? (float*)(p.ws + WS_H) + (size_t)row * 1024 : (float*)(p.ws + WS_HGS) + (size_t)(row - NCTX) * 1024);
            float sq = 0.f;
#pragma unroll
            for (int ni = 0; ni < 4; ++ni) {
                int col = cbase + ni * 16;
                float4 xv = *(const float4*)(xp + col);
                const float4 xo = make_float4(xv.x + gate[ni][0] * acc[mi][ni][0], xv.y + gate[ni][1] * acc[mi][ni][1],
                                              xv.z + gate[ni][2] * acc[mi][ni][2], xv.w + gate[ni][3] * acc[mi][ni][3]);
                *(float4*)(xn + col) = xo;
                if (l == 0) {
                    sq += xo.x * xo.x + xo.y * xo.y + xo.z * xo.z + xo.w * xo.w;
                    *(uint2*)((bf16_t*)(p.ws + WS_H) + (size_t)row * 1024 + col) =
                        make_uint2(pack2(xo.x * sc1[ni][0], xo.y * sc1[ni][1]), pack2(xo.z * sc1[ni][2], xo.w * sc1[ni][3]));
                }
            }
            if (l == 0) {
                sq += __shfl_xor(sq, 16);
                sq += __shfl_xor(sq, 32);
                if ((lane >> 4) == 0) ((float*)(p.ws + WS_SSQ))[(size_t)((n0 >> 7) * 2 + wc) * NTOK + row] = sq;
            }
        }
    }
}

DEV void prep_chunk(const P& p, int l, int item, char* smem) {
    bf16_t* vbuf = (bf16_t*)smem;
    const float* z = (const float*)(p.ws + WS_Z);
    const float* tab = (const float*)(p.ws + WS_ROPE);
    bf16_t* Kd = (bf16_t*)(p.ws + WS_KD);
    bf16_t* VdT = (bf16_t*)(p.ws + WS_VDT);
    bf16_t* Kmla = (bf16_t*)(p.ws + WS_KMLA);
    bf16_t* cqn = (bf16_t*)(p.ws + WS_CQN);
    bf16_t* ckvn = (bf16_t*)(p.ws + WS_CKVN);
    const int part = item % 3;
    const int r0 = (item / 3) * 64;
    int seq, key0, tokb = 0, cb = 0, p0 = 0;
    bool cached = false, rope = false;
    if (r0 < NCTX) { seq = r0 >> 8; key0 = r0 & 255; tokb = r0; }
    else {
        int rr = r0 - NCTX; cb = rr / 2304; key0 = rr % 2304; seq = 16 + cb;
        if (key0 < 2048) { tokb = NCTX + cb * 2048 + key0; rope = true; }
        else { cached = true; p0 = key0 - 2048; }
    }
    const int lane = ltid() & 63, wave = ltid() >> 6;
#pragma unroll 4
    for (int i = wave; i < 64; i += 4) {
        const int kr = r0 + i;
        const float *dk, *dv, *krs, *ckv, *cq = nullptr;
        if (!cached) {
            const float* zr = z + (size_t)(tokb + i) * ZW;
            dk = zr + Z_DAK; dv = zr + Z_DAV; krs = zr + Z_KR; ckv = zr + Z_CKV; cq = zr + Z_CQ;
        } else {
            size_t bp = (size_t)((cb * 2 + l) * 256 + p0 + i);
            dk = p.cdk + bp * 256; dv = p.cdv + bp * 256; krs = p.ckrope + bp * 32; ckv = p.cckv + bp * 128;
        }
        const int t = key0 + i;
        if (part == 0) {
            float4 x = ((const float4*)dk)[lane];
            float xs[4] = {x.x, x.y, x.z, x.w};
            float px[4];
#pragma unroll
            for (int e = 0; e < 4; ++e) px[e] = __shfl_xor(xs[e], 2);
            if (rope) {
                int sect = (lane & 7) >> 2;
                int pos = sect ? (t & 63) : (t >> 6);
                bool lo = (lane & 3) < 2;
#pragma unroll
                for (int e = 0; e < 4; ++e) {
                    int f = 4 * (lane & 1) + e;
                    float cs = tab[(pos * 8 + f) * 2], sn = tab[(pos * 8 + f) * 2 + 1];
                    xs[e] = lo ? xs[e] * cs - px[e] * sn : px[e] * sn + xs[e] * cs;
                }
            }
            *(uint2*)(Kd + (size_t)kr * 256 + lane * 4) = make_uint2(pack2(xs[0], xs[1]), pack2(xs[2], xs[3]));
        }
        if (part == 1) {
            float4 x = ((const float4*)dv)[lane];
            *(uint2*)(vbuf + i * 260 + lane * 4) = make_uint2(pack2(x.x, x.y), pack2(x.z, x.w));
        }
        if (part == 2) {
            int l8 = lane & 7;
            float4 x = ((const float4*)krs)[l8];
            float xs[4] = {x.x, x.y, x.z, x.w};
            float px[4];
#pragma unroll
            for (int e = 0; e < 4; ++e) px[e] = __shfl_xor(xs[e], 2);
            if (rope) {
                int sect = l8 >> 2;
                int pos = sect ? (t & 63) : (t >> 6);
                bool lo = (l8 & 3) < 2;
#pragma unroll
                for (int e = 0; e < 4; ++e) {
                    int f = 4 * (l8 & 1) + e;
                    float cs = tab[(pos * 8 + f) * 2], sn = tab[(pos * 8 + f) * 2 + 1];
                    xs[e] = lo ? xs[e] * cs - px[e] * sn : px[e] * sn + xs[e] * cs;
                }
            }
            if (lane < 8) *(uint2*)((bf16_t*)(p.ws + WS_KROPE) + (size_t)kr * 32 + l8 * 4) = make_uint2(pack2(xs[0], xs[1]), pack2(xs[2], xs[3]));
        }
        if (part == 2) {
            float4 x = lane < 32 ? ((const float4*)ckv)[lane] : make_float4(0.f, 0.f, 0.f, 0.f);
            float o0 = x.x, o1 = x.y, o2 = x.z, o3 = x.w;
            if (!cached) {
                float ss = wave_sum(x.x * x.x + x.y * x.y + x.z * x.z + x.w * x.w);
                float rstd = rsqrtf(ss * (1.f / 128.f) + EPS);
                if (lane < 32) {
                    float4 g = ((const float4*)(p.mla_kv_norm + l * 128))[lane];
                    o0 = x.x * rstd * g.x; o1 = x.y * rstd * g.y; o2 = x.z * rstd * g.z; o3 = x.w * rstd * g.w;
                    if (r0 < NCTX) {
                        int b = kr >> 8, tt = kr & 255;
                        *(float4*)(p.out + O_CKV + (size_t)((b * 2 + l) * 256 + tt) * 128 + lane * 4) = make_float4(o0, o1, o2, o3);
                    }
                }
            }
            if (lane < 32) *(uint2*)(ckvn + (size_t)kr * 128 + lane * 4) = make_uint2(pack2(o0, o1), pack2(o2, o3));
        }
        if (part == 2 && !cached) {
            float4 x = lane < 48 ? ((const float4*)cq)[lane] : make_float4(0.f, 0.f, 0.f, 0.f);
            float ss = wave_sum(x.x * x.x + x.y * x.y + x.z * x.z + x.w * x.w);
            float rstd = rsqrtf(ss * (1.f / 192.f) + EPS);
            if (lane < 48) {
                float4 g = ((const float4*)(p.mla_q_norm + l * 192))[lane];
                *(uint2*)(cqn + (size_t)(tokb + i) * 192 + lane * 4) =
                    make_uint2(pack2(x.x * rstd * g.x, x.y * rstd * g.y), pack2(x.z * rstd * g.z, x.w * rstd * g.w));
            }
        }
    }
    if (part != 1) return;
    __syncthreads();
    {
        const int c = ltid(), lk = seq_lk(seq);
        bf16_t* dst = VdT + seq_vt0(seq) + (size_t)c * lk + key0;
#pragma unroll
        for (int q = 0; q < 8; ++q) {
            uint32_t w[4];
#pragma unroll
            for (int e = 0; e < 4; ++e) w[e] = (uint32_t)vbuf[(q * 8 + 2 * e) * 260 + c] | ((uint32_t)vbuf[(q * 8 + 2 * e + 1) * 260 + c] << 16);
            *(uint4*)(dst + q * 8) = make_uint4(w[0], w[1], w[2], w[3]);
        }
    }
    __syncthreads();
}

DEV void s5_params(const P& p, int l, int dir, int g, int lane, float& abr, float& abi, float (&bbr)[16], float (&bbi)[16]) {
    const int ldg = (l * 2 + dir) * 16 + g;
    float step = expf(p.s5_log_dt[ldg]);
    float are = p.s5_a_re[ldg * 64 + lane], aim = p.s5_a_im[ldg * 64 + lane];
    float mag = expf(are * step);
    float ang = aim * step;
    abr = mag * cosf(ang);
    abi = mag * sinf(ang);
    float den = are * are + aim * aim;
    float fre = ((abr - 1.f) * are + abi * aim) / den, fim = (abi * are - (abr - 1.f) * aim) / den;
    const float4* br = (const float4*)(p.s5_b_re + (size_t)(ldg * 64 + lane) * 16);
    const float4* bi = (const float4*)(p.s5_b_im + (size_t)(ldg * 64 + lane) * 16);
#pragma unroll
    for (int q = 0; q < 4; ++q) {
        float4 r = br[q], im = bi[q];
        bbr[4 * q + 0] = fre * r.x - fim * im.x; bbi[4 * q + 0] = fre * im.x + fim * r.x;
        bbr[4 * q + 1] = fre * r.y - fim * im.y; bbi[4 * q + 1] = fre * im.y + fim * r.y;
        bbr[4 * q + 2] = fre * r.z - fim * im.z; bbi[4 * q + 2] = fre * im.z + fim * r.z;
        bbr[4 * q + 3] = fre * r.w - fim * im.w; bbi[4 * q + 3] = fre * im.w + fim * r.w;
    }
}
DEV void s5_bu8(const float* ubuf, int sb, int dir, const float (&bbr)[16], const float (&bbi)[16], float (&bur)[8], float (&bui)[8]) {
#pragma unroll
    for (int ii = 0; ii < 8; ++ii) {
        const int i = dir ? 7 - ii : ii;
        const float4* up = (const float4*)(ubuf + (sb * 8 + i) * 16);
        float4 u0 = up[0], u1 = up[1], u2 = up[2], u3 = up[3];
        float r0 = bbr[0] * u0.x, r1 = bbr[1] * u0.y, i0 = bbi[0] * u0.x, i1 = bbi[1] * u0.y;
        r0 += bbr[2] * u0.z; r1 += bbr[3] * u0.w; i0 += bbi[2] * u0.z; i1 += bbi[3] * u0.w;
        r0 += bbr[4] * u1.x; r1 += bbr[5] * u1.y; i0 += bbi[4] * u1.x; i1 += bbi[5] * u1.y;
        r0 += bbr[6] * u1.z; r1 += bbr[7] * u1.w; i0 += bbi[6] * u1.z; i1 += bbi[7] * u1.w;
        r0 += bbr[8] * u2.x; r1 += bbr[9] * u2.y; i0 += bbi[8] * u2.x; i1 += bbi[9] * u2.y;
        r0 += bbr[10] * u2.z; r1 += bbr[11] * u2.w; i0 += bbi[10] * u2.z; i1 += bbi[11] * u2.w;
        r0 += bbr[12] * u3.x; r1 += bbr[13] * u3.y; i0 += bbi[12] * u3.x; i1 += bbi[13] * u3.y;
        r0 += bbr[14] * u3.z; r1 += bbr[15] * u3.w; i0 += bbi[14] * u3.z; i1 += bbi[15] * u3.w;
        bur[ii] = r0 + r1; bui[ii] = i0 + i1;
    }
}
DEV void s5_stage_u(const float* __restrict__ z, int tok0, int g, int lane, float* ubuf) {
    float4 v[4];
#pragma unroll
    for (int k = 0; k < 4; ++k) v[k] = *(const float4*)(z + (size_t)(tok0 + (lane >> 2) + 16 * k) * ZW + Z_S5U + g * 16 + (lane & 3) * 4);
#pragma unroll
    for (int k = 0; k < 4; ++k) *(float4*)(ubuf + ((lane >> 2) + 16 * k) * 16 + (lane & 3) * 4) = v[k];
    __builtin_amdgcn_wave_barrier();
    asm volatile("s_waitcnt lgkmcnt(0)" ::: "memory");
}
DEV void s5a_wave(const P& p, int l, int witem, char* smem_wave) {
    float* ubuf = (float*)smem_wave;
    const int lane = ltid() & 63;
    const int g = witem & 15, dir = (witem >> 4) & 1, gc = witem >> 5;
    float abr, abi, bbr[16], bbi[16];
    s5_params(p, l, dir, g, lane, abr, abi, bbr, bbi);
    const float* z = (const float*)(p.ws + WS_Z);
    const int tok0 = gc * 64;
    s5_stage_u(z, tok0, g, lane, ubuf);
    float hr = 0.f, hi = 0.f;
#pragma unroll 2
    for (int sbi = 0; sbi < 8; ++sbi) {
        const int sb = dir ? 7 - sbi : sbi;
        float bur[8], bui[8];
        s5_bu8(ubuf, sb, dir, bbr, bbi, bur, bui);
#pragma unroll
        for (int ii = 0; ii < 8; ++ii) {
            float nr = abr * hr - abi * hi + bur[ii], ni = abr * hi + abi * hr + bui[ii];
            hr = nr; hi = ni;
        }
    }
    float2* F = (float2*)(p.ws + WS_S5F);
    F[(size_t)((gc * 2 + dir) * 16 + g) * 64 + lane] = make_float2(hr, hi);
    __builtin_amdgcn_wave_barrier();
}
constexpr int S5H = 132;
constexpr int S5B_LDS = (64 * 16 + 16 * S5H) * 4;
DEV void s5_split8(const float4 a, const float4 b, bf16x8& hi, bf16x8& lo) {
    const float x[8] = {a.x, a.y, a.z, a.w, b.x, b.y, b.z, b.w};
    union { bf16x8 v; uint32_t u[4]; } H, L;
#pragma unroll
    for (int j = 0; j < 4; ++j) {
        const uint32_t h = pack2(x[2 * j], x[2 * j + 1]);
        const float h0 = __uint_as_float(h << 16), h1 = __uint_as_float(h & 0xffff0000u);
        H.u[j] = h;
        L.u[j] = pack2(x[2 * j] - h0, x[2 * j + 1] - h1);
    }
    hi = H.v; lo = L.v;
}
DEV void s5b_wave(const P& p, int l, int witem, char* smem_wave) {
    float* ubuf = (float*)smem_wave;
    float* hb = ubuf + 64 * 16;
    const int lane = ltid() & 63;
    const int g = witem & 15, gc = witem >> 4;
    const int tok0 = gc * 64;
    const int seq = tok_seq(tok0);
    const int nch = seq < 16 ? 4 : 32;
    const int gcb = seq < 16 ? seq * 4 : 64 + (seq - 16) * 32;
    const int cis = gc - gcb;
    const float* z = (const float*)(p.ws + WS_Z);
    const float2* F = (const float2*)(p.ws + WS_S5F);
    s5_stage_u(z, tok0, g, lane, ubuf);
    float* yp = (float*)(p.ws + WS_YP);
    bf16_t* gy = (bf16_t*)(p.ws + WS_GY);
    const int ch = lane & 15, kg = lane >> 4;
    const float dch = p.s5_d[l * 256 + g * 16 + ch];
#pragma nounroll
    for (int dir = 0; dir < 2; ++dir) {
        float abr, abi, bbr[16], bbi[16];
        s5_params(p, l, dir, g, lane, abr, abi, bbr, bbi);
        float pr = abr, pi = abi;
#pragma unroll
        for (int s = 0; s < 6; ++s) { float nr = pr * pr - pi * pi, ni = 2.f * pr * pi; pr = nr; pi = ni; }
        float hr = 0.f, hi = 0.f;
        if (seq >= 16) {
            const float* h0 = p.st_s5 + ((size_t)((((seq - 16) * 2 + l) * 2 + dir) * 16 + g) * 64 + lane) * 2;
            hr = h0[0]; hi = h0[1];
        }
        const int nprior = dir ? (nch - 1 - cis) : cis;
#pragma unroll 4
        for (int j = 0; j < nprior; ++j) {
            int c = dir ? (nch - 1 - j) : j;
            float2 f = F[(size_t)(((gcb + c) * 2 + dir) * 16 + g) * 64 + lane];
            float nr = pr * hr - pi * hi + f.x, ni = pr * hi + pi * hr + f.y;
            hr = nr; hi = ni;
        }
        bf16x8 chi[4], clo[4];
        {
            const float* cr = p.s5_c_re + (size_t)((l * 2 + dir) * 16 + g) * 16 * 64 + ch * 64;
            const float* ci = p.s5_c_im + (size_t)((l * 2 + dir) * 16 + g) * 16 * 64 + ch * 64;
#pragma unroll
            for (int s = 0; s < 4; ++s) {
                const float* src = (s < 2 ? cr : ci) + 32 * (s & 1) + 8 * kg;
                float4 a = *(const float4*)src, b = *(const float4*)(src + 4);
                if (s >= 2) { a.x = -a.x; a.y = -a.y; a.z = -a.z; a.w = -a.w; b.x = -b.x; b.y = -b.y; b.z = -b.z; b.w = -b.w; }
                s5_split8(a, b, chi[s], clo[s]);
            }
        }
#pragma nounroll
        for (int sbi = 0; sbi < 4; ++sbi) {
            const int sb = dir ? 3 - sbi : sbi;
#pragma nounroll
            for (int half = 0; half < 2; ++half) {
                const int h8 = dir ? 1 - half : half;
                float bur[8], bui[8];
                s5_bu8(ubuf, sb * 2 + h8, dir, bbr, bbi, bur, bui);
#pragma unroll
                for (int ii = 0; ii < 8; ++ii) {
                    const int i = h8 * 8 + (dir ? 7 - ii : ii);
                    float nr = abr * hr - abi * hi + bur[ii], ni = abr * hi + abi * hr + bui[ii];
                    hr = nr; hi = ni;
                    hb[i * S5H + lane] = hr;
                    hb[i * S5H + 64 + lane] = hi;
                }
            }
            __builtin_amdgcn_wave_barrier();
            asm volatile("s_waitcnt lgkmcnt(0)" ::: "memory");
            f32x4 acc = {0.f, 0.f, 0.f, 0.f};
#pragma unroll
            for (int s = 0; s < 4; ++s) {
                const float* hp = hb + (lane & 15) * S5H + 32 * s + 8 * kg;
                bf16x8 ahi, alo;
                s5_split8(*(const float4*)hp, *(const float4*)(hp + 4), ahi, alo);
                acc = __builtin_amdgcn_mfma_f32_16x16x32_bf16(ahi, chi[s], acc, 0, 0, 0);
                acc = __builtin_amdgcn_mfma_f32_16x16x32_bf16(ahi, clo[s], acc, 0, 0, 0);
                acc = __builtin_amdgcn_mfma_f32_16x16x32_bf16(alo, chi[s], acc, 0, 0, 0);
            }
#pragma unroll
            for (int r = 0; r < 4; ++r) {
                const int tl = sb * 16 + kg * 4 + r;
                float* ypp = yp + ((size_t)g * NTOK + tok0 + tl) * 16 + ch;
                if (dir == 0) {
                    *ypp = acc[r];
                } else {
                    const float y0 = __hip_atomic_load(ypp, __ATOMIC_RELAXED, __HIP_MEMORY_SCOPE_AGENT);
                    const float u = ubuf[tl * 16 + ch];
                    gy[(size_t)(tok0 + tl) * 256 + g * 16 + ch] = f2bf(geluf(y0 + acc[r] + dch * u));
                }
            }
            __builtin_amdgcn_wave_barrier();
            asm volatile("s_waitcnt lgkmcnt(0)" ::: "memory");
        }
        asm volatile("s_waitcnt vmcnt(0)" ::: "memory");
        if (seq < 16 && cis == (dir ? 0 : nch - 1)) {
            float* o = p.out + O_S5 + ((size_t)(((seq * 2 + l) * 2 + dir) * 16 + g) * 64 + lane) * 2;
            o[0] = hr; o[1] = hi;
        }
    }
    __builtin_amdgcn_wave_barrier();
    asm volatile("s_waitcnt lgkmcnt(0)" ::: "memory");
}

constexpr int HS = 68;
DEV void hg_load(const P& p, int l, int gc, int hd, int dir, float* qq, float* kk, float* bq, bool want_q) {
    const float* z = (const float*)(p.ws + WS_Z);
    const int tid = ltid(), d = tid & 63, rq = tid >> 6;
    float lb = 0.f;
    if (l > 0) {
        float e0 = expf(p.hg_lb[(0 * 2 + dir) * 256 + hd * 64 + d]), e1 = expf(p.hg_lb[(1 * 2 + dir) * 256 + hd * 64 + d]);
        lb = e1 / (e0 + e1);
    }
    const int zf = dir ? Z_HGFB : Z_HGFF;
    {
        float zz[16], qv[16];
#pragma unroll
        for (int k = 0; k < 16; ++k) {
            int i = rq + 4 * k;
            int tok = gc * 64 + (dir ? 63 - i : i);
            const float* zr = z + (size_t)tok * ZW;
            zz[k] = zr[zf + hd * 64 + d];
            qv[k] = want_q ? zr[Z_HGQ + hd * 64 + d] : 0.f;
        }
#pragma unroll
        for (int k = 0; k < 16; ++k) {
            int i = rq + 4 * k;
            float sg = sigmf(zz[k]);
            bq[d * HS + i] = __logf(lb + (1.f - lb) * sg);
            kk[d * HS + i] = (1.f - lb) * sigmf(-zz[k]);
            if (want_q) qq[d * HS + i] = qv[k];
        }
    }
    __syncthreads();
    float v[16];
    {
        const float4* src = (const float4*)(bq + d * HS + rq * 16);
        float4 a0 = src[0], a1 = src[1], a2 = src[2], a3 = src[3];
        float t[16] = {a0.x, a0.y, a0.z, a0.w, a1.x, a1.y, a1.z, a1.w, a2.x, a2.y, a2.z, a2.w, a3.x, a3.y, a3.z, a3.w};
        float run = 0.f;
#pragma unroll
        for (int k = 0; k < 16; ++k) { run += t[k]; v[k] = run; }
    }
    bq[d * HS + rq * 16 + 15] = v[15];
    __syncthreads();
    float off = 0.f;
#pragma unroll
    for (int q = 0; q < 3; ++q) off += (q < rq) ? bq[d * HS + q * 16 + 15] : 0.f;
    __syncthreads();
    {
        float4* dst = (float4*)(bq + d * HS + rq * 16);
        dst[0] = make_float4(v[0] + off, v[1] + off, v[2] + off, v[3] + off);
        dst[1] = make_float4(v[4] + off, v[5] + off, v[6] + off, v[7] + off);
        dst[2] = make_float4(v[8] + off, v[9] + off, v[10] + off, v[11] + off);
        dst[3] = make_float4(v[12] + off, v[13] + off, v[14] + off, v[15] + off);
    }
    __syncthreads();
}
DEV void hga_block(const P& p, int l, int item, char* smem) {
    float* kk = (float*)smem;
    float* bq = kk + 64 * HS;
    float* vv = bq + 64 * HS;
    const int dir = item & 1, hd = (item >> 1) & 3, gc = item >> 3;
    const float* z = (const float*)(p.ws + WS_Z);
    const int tid = ltid();
    __syncthreads();
    {
        const int vq = (tid & 15) * 4, i0 = tid >> 4;
#pragma unroll
        for (int k = 0; k < 4; ++k) {
            int i = i0 + 16 * k;
            int tok = gc * 64 + (dir ? 63 - i : i);
            *(float4*)(vv + i * 64 + vq) = *(const float4*)(z + (size_t)tok * ZW + Z_HGI + hd * 64 + vq);
        }
    }
    hg_load(p, l, gc, hd, dir, nullptr, kk, bq, false);
    {
        const int d = tid & 63, rq = tid >> 6;
        const float bl = bq[d * HS + 63];
        float4* kp = (float4*)(kk + d * HS + rq * 16);
        const float4* bp = (const float4*)(bq + d * HS + rq * 16);
#pragma unroll
        for (int k = 0; k < 4; ++k) {
            float4 kv = kp[k], bv = bp[k];
            kv.x *= __expf(bl - bv.x); kv.y *= __expf(bl - bv.y); kv.z *= __expf(bl - bv.z); kv.w *= __expf(bl - bv.w);
            kp[k] = kv;
        }
    }
    __syncthreads();
    float* S = (float*)(p.ws + WS_HGS) + (size_t)item * 4096;
    float* Dd = (float*)(p.ws + WS_HGD) + (size_t)item * 64;
    if (tid < 64) Dd[tid] = __expf(bq[tid * HS + 63]);
    const int db = (tid >> 4) * 4, vb = (tid & 15) * 4;
    float acc[4][4];
#pragma unroll
    for (int a = 0; a < 4; ++a)
#pragma unroll
        for (int b = 0; b < 4; ++b) acc[a][b] = 0.f;
#pragma unroll 2
    for (int i = 0; i < 64; i += 4) {
        float4 kd[4], v4[4];
#pragma unroll
        for (int a = 0; a < 4; ++a) kd[a] = *(const float4*)(kk + (db + a) * HS + i);
#pragma unroll
        for (int ii = 0; ii < 4; ++ii) v4[ii] = *(const float4*)(vv + (i + ii) * 64 + vb);
#pragma unroll
        for (int a = 0; a < 4; ++a) {
            const float ka[4] = {kd[a].x, kd[a].y, kd[a].z, kd[a].w};
#pragma unroll
            for (int ii = 0; ii < 4; ++ii) {
                acc[a][0] += ka[ii] * v4[ii].x; acc[a][1] += ka[ii] * v4[ii].y; acc[a][2] += ka[ii] * v4[ii].z; acc[a][3] += ka[ii] * v4[ii].w;
            }
        }
    }
#pragma unroll
    for (int a = 0; a < 4; ++a) *(float4*)(S + (db + a) * 64 + vb) = make_float4(acc[a][0], acc[a][1], acc[a][2], acc[a][3]);
    __syncthreads();
}
template <int B>
DEV float hgc_run(const float* __restrict__ Sb, const float* __restrict__ Db, float* __restrict__ Sn, int nch, int gcb, int hd, int dir, int e, float S) {
    for (int c0 = 0; c0 < nch; c0 += B) {
        float dS[B], Dv[B];
        size_t its[B];
#pragma unroll
        for (int k = 0; k < B; ++k) {
            int c = dir ? nch - 1 - (c0 + k) : c0 + k;
            its[k] = (size_t)((gcb + c) * 4 + hd) * 2 + dir;
            dS[k] = Sb[its[k] * 4096 + e];
            Dv[k] = Db[its[k] * 64 + (e >> 6)];
        }
#pragma unroll
        for (int k = 0; k < B; ++k) {
            Sn[its[k] * 4096 + e] = S;
            S = S * Dv[k] + dS[k];
        }
    }
    return S;
}
DEV void hgc_block(const P& p, int l, int item) {
    const int chain = item >> 4, sl = item & 15;
    const int dir = chain & 1, hd = (chain >> 1) & 3, seq = chain >> 3;
    const int e = sl * 256 + ltid();
    const int nch = seq < 16 ? 4 : 32, gcb = seq < 16 ? seq * 4 : 64 + (seq - 16) * 32;
    const float* Sb = (const float*)(p.ws + WS_HGS);
    float* Sn = p.out + O_YP;
    const float* Db = (const float*)(p.ws + WS_HGD);
    float S = 0.f;
    if (seq >= 16) S = p.st_hg[(size_t)((((seq - 16) * 2 + l) * 2 + dir) * 4 + hd) * 4096 + e];
    S = (seq >= 16) ? hgc_run<16>(Sb, Db, Sn, nch, gcb, hd, dir, e, S) : hgc_run<4>(Sb, Db, Sn, nch, gcb, hd, dir, e, S);
    if (seq < 16) p.out[O_HG + (size_t)(((seq * 2 + l) * 2 + dir) * 4 + hd) * 4096 + e] = S;
}
DEV void hgb_block(const P& p, int l, int item, char* smem) {
    float* qq = (float*)smem;
    float* kk = qq + 64 * HS;
    float* bq = kk + 64 * HS;
    float* sc = bq + 64 * HS;
    const int hd = item & 3, gc = item >> 2;
    const float* z = (const float*)(p.ws + WS_Z);
    const int tid = ltid();
    __syncthreads();
    const int tb = (tid >> 4) * 4, vb = (tid & 15) * 4;
    float o[4][4];
#pragma unroll
    for (int a = 0; a < 4; ++a)
#pragma unroll
        for (int b = 0; b < 4; ++b) o[a][b] = 0.f;
#pragma nounroll
    for (int dir = 0; dir < 2; ++dir) {
        hg_load(p, l, gc, hd, dir, qq, kk, bq, true);
        const float* Sin = (const float*)(p.out + O_YP) + (size_t)((gc * 4 + hd) * 2 + dir) * 4096;
        const int pvq = (tid & 15) * 4, pr0 = tid >> 4;
#define HG_PF(k_, pvk_, psk_)                                                                     \
        {                                                                                             \
            const int i_ = pr0 + 16 * (k_);                                                           \
            const int tok_ = gc * 64 + (dir ? 63 - i_ : i_);                                          \
            pvk_ = *(const float4*)(z + (size_t)tok_ * ZW + Z_HGI + hd * 64 + pvq);                   \
            psk_ = *(const float4*)(Sin + i_ * 64 + pvq);                                             \
        }
        float4 pv0, pv1, pv2, pv3, ps0, ps1, ps2, ps3;
        HG_PF(0, pv0, ps0) HG_PF(1, pv1, ps1) HG_PF(2, pv2, ps2) HG_PF(3, pv3, ps3)
        {
            const int ib = (tid >> 4) * 4, sbk = (tid & 15) * 4;
            float a[4][4];
#pragma unroll
            for (int x = 0; x < 4; ++x)
#pragma unroll
                for (int y = 0; y < 4; ++y) a[x][y] = 0.f;
            if (sbk < ib) {
#pragma unroll 2
                for (int d = 0; d < 64; ++d) {
                    const float4 qi = *(const float4*)(qq + d * HS + ib), bi = *(const float4*)(bq + d * HS + ib);
                    const float4 ks = *(const float4*)(kk + d * HS + sbk), bs = *(const float4*)(bq + d * HS + sbk);
                    const float br = bi.x;
                    const float qe[4] = {qi.x, qi.y * __expf(bi.y - br), qi.z * __expf(bi.z - br), qi.w * __expf(bi.w - br)};
                    const float kf[4] = {ks.x * __expf(br - bs.x), ks.y * __expf(br - bs.y), ks.z * __expf(br - bs.z), ks.w * __expf(br - bs.w)};
#pragma unroll
                    for (int x = 0; x < 4; ++x)
#pragma unroll
                        for (int y = 0; y < 4; ++y) a[x][y] += qe[x] * kf[y];
                }
            } else if (sbk == ib) {
#pragma unroll 2
                for (int d = 0; d < 64; ++d) {
                    const float4 qi = *(const float4*)(qq + d * HS + ib), bi = *(const float4*)(bq + d * HS + ib);
                    const float4 ks = *(const float4*)(kk + d * HS + sbk);
                    const float qx[4] = {qi.x, qi.y, qi.z, qi.w}, bx[4] = {bi.x, bi.y, bi.z, bi.w}, ky[4] = {ks.x, ks.y, ks.z, ks.w};
#pragma unroll
                    for (int x = 0; x < 4; ++x)
#pragma unroll
                        for (int y = 0; y < 4; ++y)
                            if (y <= x) a[x][y] += qx[x] * ky[y] * __expf(bx[x] - bx[y]);
                }
            }
#pragma unroll
            for (int y = 0; y < 4; ++y) *(float4*)(sc + (sbk + y) * HS + ib) = make_float4(a[0][y], a[1][y], a[2][y], a[3][y]);
        }
        __syncthreads();
        float* vt_ = kk;
        float* st_ = bq;
        *(float4*)(vt_ + (pr0 + 0) * 64 + pvq) = pv0; *(float4*)(vt_ + (pr0 + 16) * 64 + pvq) = pv1;
        *(float4*)(vt_ + (pr0 + 32) * 64 + pvq) = pv2; *(float4*)(vt_ + (pr0 + 48) * 64 + pvq) = pv3;
        {
            const int d = tid & 63, rq = tid >> 6;
            float4* qp = (float4*)(qq + d * HS + rq * 16);
            const float4* bp = (const float4*)(bq + d * HS + rq * 16);
#pragma unroll
            for (int k = 0; k < 4; ++k) {
                float4 qv = qp[k], bv = bp[k];
                qv.x *= __expf(bv.x); qv.y *= __expf(bv.y); qv.z *= __expf(bv.z); qv.w *= __expf(bv.w);
                qp[k] = qv;
            }
        }
        __syncthreads();
        *(float4*)(st_ + (pr0 + 0) * 64 + pvq) = ps0; *(float4*)(st_ + (pr0 + 16) * 64 + pvq) = ps1;
        *(float4*)(st_ + (pr0 + 32) * 64 + pvq) = ps2; *(float4*)(st_ + (pr0 + 48) * 64 + pvq) = ps3;
        __syncthreads();
        const int i0 = dir ? 60 - tb : tb;
#pragma unroll 4
        for (int s = 0; s < 64; ++s) {
            const float4 v4 = *(const float4*)(vt_ + s * 64 + vb);
            const float4 s4 = *(const float4*)(st_ + s * 64 + vb);
            const float4 w4 = *(const float4*)(sc + s * HS + i0);
            const float4 q4 = *(const float4*)(qq + s * HS + i0);
            const float w[4] = {dir ? w4.w : w4.x, dir ? w4.z : w4.y, dir ? w4.y : w4.z, dir ? w4.x : w4.w};
            const float qe[4] = {dir ? q4.w : q4.x, dir ? q4.z : q4.y, dir ? q4.y : q4.z, dir ? q4.x : q4.w};
#pragma unroll
            for (int x = 0; x < 4; ++x) {
                o[x][0] += w[x] * v4.x + qe[x] * s4.x;
                o[x][1] += w[x] * v4.y + qe[x] * s4.y;
                o[x][2] += w[x] * v4.z + qe[x] * s4.z;
                o[x][3] += w[x] * v4.w + qe[x] * s4.w;
            }
        }
        __syncthreads();
    }
    bf16_t* mixed = (bf16_t*)(p.out + 4194304);
    const float4 g4 = *(const float4*)(p.hg_norm + l * 64 + vb);
#pragma unroll
    for (int x = 0; x < 4; ++x) {
        float ss = o[x][0] * o[x][0] + o[x][1] * o[x][1] + o[x][2] * o[x][2] + o[x][3] * o[x][3];
        ss += __shfl_xor(ss, 1); ss += __shfl_xor(ss, 2); ss += __shfl_xor(ss, 4); ss += __shfl_xor(ss, 8);
        float rstd = rsqrtf(ss * (1.f / 64.f) + EPS);
        int tok = gc * 64 + tb + x;
        float4 gt = *(const float4*)(z + (size_t)tok * ZW + Z_HGG + hd * 64 + vb);
        float y0 = o[x][0] * rstd * g4.x * siluf(gt.x), y1 = o[x][1] * rstd * g4.y * siluf(gt.y);
        float y2 = o[x][2] * rstd * g4.z * siluf(gt.z), y3 = o[x][3] * rstd * g4.w * siluf(gt.w);
        *(uint2*)(mixed + (size_t)tok * 1024 + 512 + hd * 64 + vb) = make_uint2(pack2(y0, y1), pack2(y2, y3));
    }
}

constexpr float ATT_THR = 5.0f;
template <int NC, int NDS>
DEV void attn_block(const float* __restrict__ qsrc, int qstride, const bf16_t* __restrict__ kbase, int kstride, const bf16_t* __restrict__ vt,
                    int Lk, const float* __restrict__ tab, bool rope, int t0, float qscale, float lam, float post,
                    const float* __restrict__ norm_g, const float* __restrict__ gate, bf16_t* __restrict__ outp, char* smem,
                    const bf16_t* __restrict__ krope) {
    constexpr int KW = NC * NDS * 16;
    constexpr int KP = KW + 8;
    constexpr int RC = KW / 8;
    constexpr int NKC = (64 * RC) / 256;
    constexpr int KS_STAGE = 64 * KP;
    constexpr int VS_STAGE = 64 * 72;
    bf16_t* Ks = (bf16_t*)smem;
    bf16_t* Vs = Ks + 2 * KS_STAGE;
    const int tid = ltid(), lane = tid & 63, wave = tid >> 6, r = lane & 31, hh = lane >> 5;
    __syncthreads();
    bf16x8 qf[NC][NDS];
    {
        const float* qs = qsrc + (size_t)(wave * 32 + r) * qstride;
#pragma unroll
        for (int c = 0; c < NC; ++c)
#pragma unroll
            for (int ds = 0; ds < NDS; ++ds) {
                const float* s = qs + (c * NDS + ds) * 16 + 8 * hh;
                float4 a = *(const float4*)s, b = *(const float4*)(s + 4);
                float x[8] = {a.x, a.y, a.z, a.w, b.x, b.y, b.z, b.w};
                if (ds >= NDS - 2) {
                    float px[8];
#pragma unroll
                    for (int j = 0; j < 8; ++j) px[j] = __shfl_xor(x[j], 32);
                    if (rope) {
                        int t = t0 + wave * 32 + r;
                        int pos = (ds == NDS - 2) ? (t >> 6) : (t & 63);
#pragma unroll
                        for (int j = 0; j < 8; ++j) {
                            float cs = tab[(pos * 8 + j) * 2], sn = tab[(pos * 8 + j) * 2 + 1];
                            x[j] = hh == 0 ? x[j] * cs - px[j] * sn : px[j] * sn + x[j] * cs;
                        }
                    }
                }
                union { bf16x8 v; uint32_t u[4]; } pk;
#pragma unroll
                for (int j = 0; j < 4; ++j) pk.u[j] = pack2(x[2 * j] * qscale, x[2 * j + 1] * qscale);
                qf[c][ds] = pk.v;
            }
    }
    f32x16 O[NC][2];
    float m[NC], ls[NC];
#pragma unroll
    for (int c = 0; c < NC; ++c) {
        m[c] = -1e30f; ls[c] = 0.f;
#pragma unroll
        for (int e = 0; e < 16; ++e) { O[c][0][e] = 0.f; O[c][1][e] = 0.f; }
    }
    uint4 rkA0, rkA1, rkA2, rvA0, rvA1, rkB0, rkB1, rkB2, rvB0, rvB1;
    const int vrow = tid >> 3, vcc = tid & 7;
#define ATT_GL1(dst_, i_, key0_)                                                                                                 \
    {                                                                                                                            \
        const int c = tid + 256 * (i_);                                                                                          \
        const int cc_ = c % RC, row_ = (key0_) + c / RC;                                                                         \
        dst_ = (RC <= 8 || cc_ < 8) ? *(const uint4*)(kbase + (size_t)row_ * kstride + cc_ * 8)                                  \
                                    : *(const uint4*)(krope + (size_t)row_ * 32 + (cc_ - 8) * 8);                                \
    }
#define ATT_GLOAD(S_, key0_)                                                                                                     \
    {                                                                                                                            \
        ATT_GL1(rk##S_##0, 0, key0_) ATT_GL1(rk##S_##1, 1, key0_)                                                                \
        if (NKC > 2) ATT_GL1(rk##S_##2, 2, key0_)                                                                                \
        rv##S_##0 = *(const uint4*)(vt + (size_t)vrow * Lk + (key0_) + vcc * 8);                                                 \
        rv##S_##1 = *(const uint4*)(vt + (size_t)(vrow + 32) * Lk + (key0_) + vcc * 8);                                          \
    }
#define ATT_SW1(src_, i_, buf_)                                                                                                  \
    {                                                                                                                            \
        const int c = tid + 256 * (i_);                                                                                          \
        *(uint4*)(Ks + (buf_) * KS_STAGE + (c / RC) * KP + (c % RC) * 8) = src_;                                                 \
    }
#define ATT_SWRITE(S_, buf_)                                                                                                     \
    {                                                                                                                            \
        ATT_SW1(rk##S_##0, 0, buf_) ATT_SW1(rk##S_##1, 1, buf_)                                                                  \
        if (NKC > 2) ATT_SW1(rk##S_##2, 2, buf_)                                                                                 \
        *(uint4*)(Vs + (buf_) * VS_STAGE + vrow * 72 + vcc * 8) = rv##S_##0;                                                     \
        *(uint4*)(Vs + (buf_) * VS_STAGE + (vrow + 32) * 72 + vcc * 8) = rv##S_##1;                                              \
    }
#define ATT_QK(step_, dst_)                                                                                          \
        {                                                                                                            \
            const int sub_ = (step_) / NC, c_ = (step_) % NC;                                                        \
            _Pragma("unroll") for (int e = 0; e < 16; ++e) dst_[e] = 0.f;                                            \
            _Pragma("unroll") for (int ds = 0; ds < NDS; ++ds) {                                                     \
                bf16x8 kf = *(const bf16x8*)(Kc + sub_ * 32 * KP + (c_ * NDS + ds) * 16);                            \
                dst_ = __builtin_amdgcn_mfma_f32_32x32x16_bf16(kf, qf[c_][ds], dst_, 0, 0, 0);                       \
            }                                                                                                        \
        }
#define ATT_COMPUTE(cur_)  { \
        const bf16_t* Kc = Ks + (cur_) * KS_STAGE + r * KP + 8 * hh; \
        const bf16_t* Vc = Vs + (cur_) * VS_STAGE + r * 72 + 4 * hh; \
        constexpr int NSTEP = 2 * NC; \
        f32x16 Sb[2]; \
        bf16x8 vf[2][2]; \
        ATT_QK(0, Sb[0]) \
        _Pragma("unroll") for (int step = 0; step < NSTEP; ++step) { \
        const int sub = step / NC, c = step % NC; \
        if (step + 1 < NSTEP) ATT_QK(step + 1, Sb[(step + 1) & 1]) \
        if (c == 0) { \
        _Pragma("unroll") for (int dvb = 0; dvb < 2; ++dvb) \
        _Pragma("unroll") for (int s = 0; s < 2; ++s) { \
        const bf16_t* vp = Vc + dvb * 32 * 72 + sub * 32 + 16 * s; \
        uint2 lo = *(const uint2*)vp, hi = *(const uint2*)(vp + 8); \
        union { bf16x8 v; uint32_t u[4]; } pk; \
        pk.u[0] = lo.x; pk.u[1] = lo.y; pk.u[2] = hi.x; pk.u[3] = hi.y; \
        vf[dvb][s] = pk.v; \
        } \
        } \
        f32x16 S = Sb[step & 1]; \
        float mx = S[0]; \
        _Pragma("unroll") for (int e = 1; e < 16; ++e) mx = fmaxf(mx, S[e]); \
        { \
        const auto sw = __builtin_amdgcn_permlane32_swap(__float_as_uint(mx), __float_as_uint(mx), false, false); \
        mx = fmaxf(__uint_as_float(sw[0]), __uint_as_float(sw[1])); \
        } \
        if (__builtin_amdgcn_ballot_w64(mx - m[c] > ATT_THR) != 0ull) { \
        const float mn = fmaxf(m[c], mx); \
        const float alpha = __builtin_amdgcn_exp2f(m[c] - mn); \
        m[c] = mn; \
        ls[c] *= alpha; \
        _Pragma("unroll") for (int e = 0; e < 16; ++e) { O[c][0][e] *= alpha; O[c][1][e] *= alpha; } \
        } \
        const float mcur = m[c]; \
        float rs = 0.f; \
        _Pragma("unroll") for (int e = 0; e < 16; ++e) { S[e] = __builtin_amdgcn_exp2f(S[e] - mcur); rs += S[e]; } \
        ls[c] += rs; \
        _Pragma("unroll") for (int s = 0; s < 2; ++s) { \
        union { bf16x8 v; uint32_t u[4]; } pk; \
        _Pragma("unroll") for (int j = 0; j < 4; ++j) pk.u[j] = pack2(S[8 * s + 2 * j], S[8 * s + 2 * j + 1]); \
        O[c][0] = __builtin_amdgcn_mfma_f32_32x32x16_bf16(vf[0][s], pk.v, O[c][0], 0, 0, 0); \
        O[c][1] = __builtin_amdgcn_mfma_f32_32x32x16_bf16(vf[1][s], pk.v, O[c][1], 0, 0, 0); \
        } \
        } \
    }
    constexpr int NSTEP = 2 * NC;
    const int nt = Lk >> 6;
    rkA2 = make_uint4(0u, 0u, 0u, 0u); rkB2 = rkA2;
    ATT_GLOAD(A, 0)
    ATT_SWRITE(A, 0)
    ATT_GLOAD(B, 64)
    __syncthreads();
    for (int kt = 0; kt < nt; kt += 2) {
        if (kt + 2 < nt) ATT_GLOAD(A, (kt + 2) * 64)
        ATT_COMPUTE(0)
        ATT_SWRITE(B, 1)
        __syncthreads();
        if (kt + 3 < nt) ATT_GLOAD(B, (kt + 3) * 64)
        ATT_COMPUTE(1)
        if (kt + 2 < nt) ATT_SWRITE(A, 0)
        __syncthreads();
    }
#undef ATT_QK
#undef ATT_COMPUTE
#undef ATT_GLOAD
#undef ATT_GL1
#undef ATT_SWRITE
#undef ATT_SW1
    float inv[NC];
#pragma unroll
    for (int c = 0; c < NC; ++c) { float lt = ls[c] + __shfl_xor(ls[c], 32); inv[c] = 1.f / lt; }
    float o[2][16];
    float ss = 0.f;
#pragma unroll
    for (int dvb = 0; dvb < 2; ++dvb)
#pragma unroll
        for (int e = 0; e < 16; ++e) {
            float v = O[0][dvb][e] * inv[0];
            if constexpr (NC == 2) v -= lam * O[1][dvb][e] * inv[1];
            o[dvb][e] = v;
            ss += v * v;
        }
    float rstd = 1.f;
    if constexpr (NC == 2) {
        ss += __shfl_xor(ss, 32);
        rstd = rsqrtf(ss * (1.f / 64.f) + EPS) * post;
    }
    const int qrow = wave * 32 + r;
#pragma unroll
    for (int dvb = 0; dvb < 2; ++dvb)
#pragma unroll
        for (int g4 = 0; g4 < 4; ++g4) {
            int dv = dvb * 32 + 8 * g4 + 4 * hh;
            float4 gt = *(const float4*)(gate + (size_t)qrow * ZW + dv);
            float y0 = o[dvb][4 * g4 + 0] * rstd * siluf(gt.x), y1 = o[dvb][4 * g4 + 1] * rstd * siluf(gt.y);
            float y2 = o[dvb][4 * g4 + 2] * rstd * siluf(gt.z), y3 = o[dvb][4 * g4 + 3] * rstd * siluf(gt.w);
            if constexpr (NC == 2) {
                float4 ng = *(const float4*)(norm_g + dv);
                y0 *= ng.x; y1 *= ng.y; y2 *= ng.z; y3 *= ng.w;
            }
            *(uint2*)(outp + (size_t)qrow * 1024 + dv) = make_uint2(pack2(y0, y1), pack2(y2, y3));
        }
}

DEV void attn_item(const P& p, int l, int kind, int seq, int hd, int qb, char* smem) {
    const float* z = (const float*)(p.ws + WS_Z);
    const float* tab = (const float*)(p.ws + WS_ROPE);
    const float* lamp = (const float*)(p.ws + WS_LAM);
    bf16_t* mixed = (bf16_t*)(p.out + 4194304);
    const int tq0 = seq_tok0(seq) + qb * 128, kr0 = seq_kr0(seq), lk = seq_lk(seq);
    const bool rope = seq >= 16;
    const float LOG2E = 1.4426950408889634f;
    if (kind == 0) {
        attn_block<2, 2>(z + (size_t)tq0 * ZW + Z_DAQ + hd * 64, ZW, (const bf16_t*)(p.ws + WS_KD) + (size_t)kr0 * 256 + hd * 64, 256,
                         (const bf16_t*)(p.ws + WS_VDT) + seq_vt0(seq) + (size_t)hd * 64 * lk, lk, tab, rope, qb * 128,
                         0.17677669529663687f * LOG2E, lamp[l], 1.f - lamp[2 + l], p.da_norm + l * 64,
                         z + (size_t)tq0 * ZW + Z_DAG + hd * 64, mixed + (size_t)tq0 * 1024 + hd * 64, smem, nullptr);
    } else {
        attn_block<1, 6>((const float*)(p.ws + WS_QRAW) + (size_t)tq0 * 384 + hd * 96, 384, (const bf16_t*)(p.ws + WS_KMLA) + (size_t)kr0 * 384 + hd * 96, 384,
                         (const bf16_t*)(p.ws + WS_VMT) + seq_vt0(seq) + (size_t)hd * 64 * lk, lk, tab, rope, qb * 128,
                         0.10206207261596575f * LOG2E, 0.f, 1.f, nullptr,
                         z + (size_t)tq0 * ZW + Z_MLAG + hd * 64, mixed + (size_t)tq0 * 1024 + 768 + hd * 64, smem,
                         (const bf16_t*)(p.ws + WS_KROPE) + (size_t)kr0 * 32);
    }
}

#define XB_TMO      128
#define XB_XCNT(j)  (256  + 64 * (j))
#define XB_XSUB(j)  (1280 + 64 * (j))
#define XB_XGEN(j)  (2304 + 64 * (j))
#define XB_TOP      3328
#define XB_TOPGEN   3392
#define XCD_BAR_WORDS 3456
#define XB_SPIN_CAP (1u << 20)
#define LAS __attribute__((address_space(3)))
DEV unsigned xb_ld(unsigned* p) { return __hip_atomic_load(p, __ATOMIC_RELAXED, __HIP_MEMORY_SCOPE_AGENT); }
DEV unsigned xb_add(unsigned* p, unsigned v) { return __hip_atomic_fetch_add(p, v, __ATOMIC_RELAXED, __HIP_MEMORY_SCOPE_AGENT); }
DEV unsigned xb_xcc_id() { return (unsigned)__builtin_amdgcn_s_getreg((3 << 11) | 20) & 0xFu; }
#define XB_SPIN(cond, bar) do { unsigned _sp = 0; while (cond) { __builtin_amdgcn_s_sleep(1); \
    if ((++_sp & 255u) == 0u) { if (xb_ld(&(bar)[XB_TMO])) break; if (_sp > XB_SPIN_CAP) { atomicAdd(&(bar)[XB_TMO], 1u); break; } } } } while (0)
struct XcdBarrier { unsigned* bar; unsigned x; volatile LAS unsigned* st; };
DEV XcdBarrier xcd_barrier_post(unsigned* bar, volatile LAS unsigned* st) {
    XcdBarrier b; b.bar = bar; b.x = xb_xcc_id(); b.st = st;
    if (threadIdx.x == 0) (void)xb_add(&bar[XB_XCNT(b.x)], 1u);
    return b;
}
DEV void xcd_barrier_complete(unsigned* bar, unsigned x, unsigned& nloc, unsigned& nx) {
    const unsigned G = gridDim.x * gridDim.y * gridDim.z;
    unsigned sum, cnt, mine, sp = 0u;
    for (;;) {
        sum = 0u; cnt = 0u; mine = 0u;
#pragma unroll
        for (unsigned j = 0; j < 16; ++j) { const unsigned c = xb_ld(&bar[XB_XCNT(j)]); sum += c; cnt += (c > 0u) ? 1u : 0u; mine = (j == x) ? c : mine; }
        if (sum == G) break;
        __builtin_amdgcn_s_sleep(1);
        if ((++sp & 255u) == 0u) { if (xb_ld(&bar[XB_TMO])) break; if (sp > XB_SPIN_CAP) { atomicAdd(&bar[XB_TMO], 1u); break; } }
    }
    nloc = mine > 0u ? mine : 1u; nx = cnt > 0u ? cnt : 1u;
}
DEV void xcd_barrier(const XcdBarrier& b) {
    asm volatile("s_waitcnt vmcnt(0)" ::: "memory");
    __syncthreads();
    if (threadIdx.x == 0) {
        unsigned* bar = b.bar;
        __builtin_amdgcn_s_waitcnt(0);
        unsigned nloc = b.st[0], nx = b.st[1];
        if (nloc == 0u) { xcd_barrier_complete(bar, b.x, nloc, nx); b.st[0] = nloc; b.st[1] = nx; }
        const unsigned old = xb_add(&bar[XB_XSUB(b.x)], 1u);
        const unsigned gen = old / nloc;
        if (old + 1u == (gen + 1u) * nloc) {
            __builtin_amdgcn_fence(__ATOMIC_RELEASE, "agent");
            asm volatile("s_waitcnt vmcnt(0)" ::: "memory");
            const unsigned og = xb_add(&bar[XB_TOP], 1u);
            const unsigned tg = og / nx;
            if (og + 1u == (tg + 1u) * nx) xb_add(&bar[XB_TOPGEN], 1u);
            else XB_SPIN(xb_ld(&bar[XB_TOPGEN]) == tg, bar);
            __builtin_amdgcn_fence(__ATOMIC_ACQUIRE, "agent");
            xb_add(&bar[XB_XGEN(b.x)], 1u);
            asm volatile("s_waitcnt vmcnt(0)" ::: "memory");
        } else {
            XB_SPIN(xb_ld(&bar[XB_XGEN(b.x)]) == gen, bar);
            __builtin_amdgcn_fence(__ATOMIC_ACQUIRE, "agent");
            asm volatile("s_waitcnt vmcnt(0)" ::: "memory");
        }
    }
    __syncthreads();
}

DEV int sub_start(int bid, int off, int G) { int r = (bid - off) % G; return r < 0 ? r + G : r; }
__global__ void __launch_bounds__(256, 2) fwd_megakernel(P p) {
    extern __shared__ __attribute__((aligned(16))) char smem[];
    cg::grid_group grid = cg::this_grid();
    const int G = gridDim.x, bid = blockIdx.x;
    if (p.out == nullptr) grid.sync();
    volatile LAS unsigned* xst = (volatile LAS unsigned*)(smem + SMEM_WORK);
    if (threadIdx.x == 0) { xst[0] = 0u; xst[1] = 0u; xst[2] = 0u; xst[3] = 0u; }
    __syncthreads();
    const XcdBarrier xb = xcd_barrier_post((unsigned*)(p.ws + WS_BAR), xst);

    phase0(p, smem, 0);
    xcd_barrier(xb);
    phase0(p, smem, 1);
    for (int j = bid; j < ZW / 64; j += G) bias_block(p, j, smem);
    for (int e = bid * 256 + ltid(); e < 2 * 3 * 3072; e += G * 256) {
        const int j = e % 3072, lc = e / 3072;
        ((float*)(p.ws + WS_MODS))[e] = mod_val((const float*)(p.ws + WS_MODP), lc / 3, lc % 3, j);
    }
    phase_rownorm(p, 0, 0);
    xcd_barrier(xb);
    for (int rep = 0; rep < REP_SYNC; ++rep) xcd_barrier(xb);
#pragma nounroll
    for (int l = 0; l < 2; ++l) {
        for (int rep = 0; rep < REP_P1; ++rep) {
        {
            const bf16_t* A = (const bf16_t*)(p.ws + WS_H);
            const bf16_t* Bt = (const bf16_t*)(p.ws + WS_WIN) + (size_t)l * ZW * 1024;
            for (int t = bid; t < 64 * 27; t += G) gemm_tile<EPI_INPROJ>(p, l, A, 1024, Bt, 1024, 1024, (t & 63) * 128, (t >> 6) * 128, smem);
        }
        xcd_barrier(xb);
        }
        for (int rep = 0; rep < REP_X1; ++rep) {
        {
            constexpr int N_PREP = 408, N_HGA = 1024, N_S5A = 1024;
            for (int rr = 0; rr < REP_PREP; ++rr)
            for (int j = sub_start(bid, 0, G); j < N_PREP; j += G) prep_chunk(p, l, j, smem);
            for (int rr = 0; rr < REP_HGA; ++rr)
            for (int j = sub_start(bid, N_PREP, G); j < N_HGA; j += G) hga_block(p, l, j, smem);
            __syncthreads();
            for (int rr = 0; rr < REP_S5A; ++rr)
            for (int j = sub_start(bid, N_PREP + N_HGA, G); j < N_S5A; j += G) { const int wave = ltid() >> 6; s5a_wave(p, l, j * 4 + wave, smem + wave * 4096); }
        }
        xcd_barrier(xb);
        }
        for (int rep = 0; rep < REP_X2; ++rep) {
        {
            const bf16_t* cqn = (const bf16_t*)(p.ws + WS_CQN);
            const bf16_t* ckvn = (const bf16_t*)(p.ws + WS_CKVN);
            const bf16_t* WuqT = (const bf16_t*)(p.ws + WS_WUQ) + (size_t)l * 384 * 192;
            const bf16_t* WukvT = (const bf16_t*)(p.ws + WS_WUKV) + (size_t)l * 512 * 128;
            constexpr int N_UQ = 64 * 3, N_UKV = 68 * 4, N_HGC = 144 * 16;
            for (int j = sub_start(bid, 0, G); j < N_UQ; j += G) gemm_tile<EPI_UQ>(p, l, cqn, 192, WuqT, 192, 192, (j / 3) * 128, (j % 3) * 128, smem);
            for (int j = sub_start(bid, N_UQ, G); j < N_UKV; j += G) gemm_tile<EPI_UKV>(p, l, ckvn, 128, WukvT, 128, 128, (j >> 2) * 128, (j & 3) * 128, smem);
            for (int j = sub_start(bid, N_UQ + N_UKV, G); j < N_HGC; j += G) hgc_block(p, l, j);
        }
        xcd_barrier(xb);
        }
        for (int rep = 0; rep < REP_X3; ++rep) {
        {
            constexpr int N_AH = 256, N_HGB = 512, N_S5B = 512, N_AL = 256;
            for (int rr = 0; rr < REP_AH; ++rr)
            for (int j = sub_start(bid, 0, G); j < N_AH; j += G) {
                int kind = j & 1, hd = (j >> 1) & 3, sq = (j >> 3) & 1, qb = j >> 4;
                attn_item(p, l, kind, 16 + sq, hd, qb, smem);
            }
            for (int rr = 0; rr < REP_HGB; ++rr)
            for (int j = sub_start(bid, N_AH, G); j < N_HGB; j += G) hgb_block(p, l, j, smem);
            __syncthreads();
            for (int rr = 0; rr < REP_S5B; ++rr)
            for (int j = sub_start(bid, N_AH + N_HGB, G); j < N_S5B; j += G) { const int wave = ltid() >> 6; s5b_wave(p, l, j * 4 + wave, smem + wave * S5B_LDS); }
            for (int j = sub_start(bid, N_AH + N_HGB + N_S5B, G); j < N_AL; j += G) {
                int kind = j & 1, hd = (j >> 1) & 3, qb = (j >> 3) & 1, sq = j >> 4;
                attn_item(p, l, kind, sq, hd, qb, smem);
            }
        }
        xcd_barrier(xb);
        }
        for (int rep = 0; rep < REP_X4; ++rep) {
        {
            const bf16_t* gy = (const bf16_t*)(p.ws + WS_GY);
            const bf16_t* WgluT = (const bf16_t*)(p.ws + WS_WGLU) + (size_t)l * 512 * 256;
            for (int t = bid; t < 64 * 4; t += G) gemm_tile<EPI_GLU>(p, l, gy, 256, WgluT, 256, 256, (t & 63) * 128, (t >> 6) * 128, smem);
        }
        xcd_barrier(xb);
        }
        for (int rep = 0; rep < REP_P3; ++rep) {
        {
            const bf16_t* A = (const bf16_t*)(p.out + 4194304);
            const bf16_t* Bt = (const bf16_t*)(p.ws + WS_WOUT) + (size_t)l * 1024 * 1024;
            for (int t = bid; t < 64 * 8; t += G) gemm_tile<EPI_OUT>(p, l, A, 1024, Bt, 1024, 1024, (t & 63) * 128, (t >> 6) * 128, smem);
        }
        xcd_barrier(xb);
        }
    }
    phase_rownorm(p, 1, 1);
}

extern "C" void kernel_launch(void* const* d_in, const int* in_sizes, int n_in, void* d_out, int out_size, void* d_ws, size_t ws_size,
                              hipStream_t stream) {
    static int grid_blocks = 0;
    if (grid_blocks == 0) {
        int dev = 0, cus = 0, per_cu = 0;
        hipGetDevice(&dev);
        hipDeviceGetAttribute(&cus, hipDeviceAttributeMultiprocessorCount, dev);
        hipFuncSetAttribute((const void*)fwd_megakernel, hipFuncAttributeMaxDynamicSharedMemorySize, SMEM_BYTES);
        hipOccupancyMaxActiveBlocksPerMultiprocessor(&per_cu, (const void*)fwd_megakernel, 256, SMEM_BYTES);
        if (per_cu < 1) per_cu = 1;
        if (per_cu > 2) per_cu = 2;
        grid_blocks = cus * per_cu;
        if (ws_size < WS_END || n_in != 32) { fprintf(stderr, "kernel_launch: unexpected ws_size %zu / n_in %d\n", ws_size, n_in); }
    }
    if (hipMemsetAsync((char*)d_ws + WS_BAR, 0, 16384, stream) != hipSuccess) fprintf(stderr, "memset of barrier words failed\n");
    P p{};
    const float** f = (const float**)&p;
    for (int i = 0; i < 32; ++i) f[i] = (const float*)d_in[i];
    p.out = (float*)d_out;
    p.ws = (char*)d_ws;
    void* args[] = {&p};
    hipError_t e = hipLaunchCooperativeKernel((const void*)fwd_megakernel, dim3(grid_blocks), dim3(256), args, SMEM_BYTES, stream);
    if (e != hipSuccess) fprintf(stderr, "cooperative launch failed: %s (grid %d)\n", hipGetErrorString(e), grid_blocks);
}
```
